# Optimizing an MI355X kernel written in HIP

```python
import jax, jax.numpy as jnp
from jax import lax
import numpy as np

D_MODEL = 1024
BATCH = 8
SEQ = 4096
DEPTH = 4

MIX_WIDTH = D_MODEL
A_WIDTH = MIX_WIDTH // 2
B_WIDTH = MIX_WIDTH - A_WIDTH
A_HEADS = 8
A_HEAD_DIM = A_WIDTH // A_HEADS
B_HEADS = 8
CHUNK = 128
CONV_WIDTH = 3
IN_COLS = 2 * A_WIDTH + 3 * B_WIDTH
POOL_WINDOWS = (2, 4, 8, 16)
POOL_GROUPS = len(POOL_WINDOWS)
POOL_GROUP_DIM = D_MODEL // POOL_GROUPS
N_GROUPS = 4
EXPERTS_PER_GROUP = 8
N_EXPERTS = N_GROUPS * EXPERTS_PER_GROUP
TOP_K = 2
D_EXPERT = D_MODEL // 2
DISPATCH_BLOCK = 128
EPS = 1e-6
N_EVEN = (DEPTH + 1) // 2
N_ODD = DEPTH // 2

kernel_name = "hybrid_sgu_conv_pool_hmoe_adaln"


def rmsnorm(x, g):
    xf = x.astype(jnp.float32)
    y = xf * lax.rsqrt(jnp.mean(xf * xf, axis=-1, keepdims=True) + EPS)
    return (y * g.astype(jnp.float32)).astype(x.dtype)


def chunk_sgu(u, v, g_v, w_s, b_s):
    bsz, s, _ = v.shape
    n_chunks = s // CHUNK
    vh = v.reshape(bsz, n_chunks, CHUNK, A_HEADS, A_HEAD_DIM)
    vh = rmsnorm(vh, g_v.reshape(A_HEADS, A_HEAD_DIM))
    causal = jnp.tril(jnp.ones((CHUNK, CHUNK), dtype=bool))
    w = jnp.where(causal[None], w_s, 0).astype(v.dtype)
    sv = jnp.einsum('hts,bnshd->bnthd', w, vh)
    sv = sv + b_s.T[None, None, :, :, None].astype(v.dtype)
    return u * sv.reshape(bsz, s, A_WIDTH)


def short_gated_conv(b_gate, c_gate, x_in, conv_w):
    z = c_gate * x_in
    s = z.shape[1]
    zp = jnp.pad(z, ((0, 0), (CONV_WIDTH - 1, 0), (0, 0)))
    conv = sum(conv_w[k] * zp[:, k:k + s] for k in range(CONV_WIDTH))
    return b_gate * conv


def pool_mixer(h, w_pool, pool_scale):
    s = h.shape[1]
    hf = h.astype(jnp.float32)
    csum = jnp.cumsum(hf, axis=1)
    t = jnp.arange(s)
    outs = []
    for g, win in enumerate(POOL_WINDOWS):
        sl = slice(g * POOL_GROUP_DIM, (g + 1) * POOL_GROUP_DIM)
        cg = csum[..., sl]
        lagged = jnp.pad(cg, ((0, 0), (win, 0), (0, 0)))[:, :s]
        count = jnp.minimum(t + 1, win).astype(jnp.float32)[None, :, None]
        pooled = (cg - lagged) / count - hf[..., sl]
        outs.append(pooled.astype(h.dtype) @ w_pool[g])
    return jnp.concatenate(outs, axis=-1) * pool_scale


def routed_experts(hf, expert_id, gate, w_gate, w_up, w_down):
    t_tok, d = hf.shape
    n_assign = t_tok * TOP_K
    flat_e = expert_id.reshape(n_assign)
    flat_g = gate.reshape(n_assign)
    flat_tok = jnp.repeat(jnp.arange(t_tok, dtype=jnp.int32), TOP_K)
    order = jnp.argsort(flat_e)
    sorted_e = flat_e[order]
    counts = jnp.bincount(flat_e, length=N_EXPERTS)
    starts = jnp.cumsum(counts) - counts
    padded = (counts + DISPATCH_BLOCK - 1) // DISPATCH_BLOCK * DISPATCH_BLOCK
    pad_ends = jnp.cumsum(padded)
    pad_starts = pad_ends - padded
    dest = pad_starts[sorted_e] + jnp.arange(n_assign) - starts[sorted_e]
    n_blocks = (n_assign + DISPATCH_BLOCK - 1) // DISPATCH_BLOCK + N_EXPERTS
    n_rows = n_blocks * DISPATCH_BLOCK
    buf_tok = jnp.full((n_rows,), t_tok, jnp.int32).at[dest].set(flat_tok[order])
    buf_gate = jnp.zeros((n_rows,), hf.dtype).at[dest].set(flat_g[order].astype(hf.dtype))
    blk_expert = jnp.minimum(
        jnp.searchsorted(pad_ends, jnp.arange(n_blocks) * DISPATCH_BLOCK, side='right'),
        N_EXPERTS - 1)
    x_pad = jnp.concatenate([hf, jnp.zeros((1, d), hf.dtype)], axis=0)
    xb = x_pad[buf_tok].reshape(n_blocks, DISPATCH_BLOCK, d)

    def run_block(args):
        xblk, e = args
        a = xblk @ w_gate[e]
        b = xblk @ w_up[e]
        return (jax.nn.silu(a) * b) @ w_down[e]

    yb = lax.map(run_block, (xb, blk_expert)).reshape(n_rows, d)
    out = jax.ops.segment_sum(yb * buf_gate[:, None], buf_tok, num_segments=t_tok + 1)
    return out[:t_tok]


def hier_moe(h, w_gr, b_gr, w_er, b_er, w_gate, w_up, w_down):
    bsz, s, d = h.shape
    t_tok = bsz * s
    hf = h.reshape(t_tok, d)
    rows = jnp.arange(t_tok)
    g_logits = (hf @ w_gr + b_gr).astype(jnp.float32)
    g_prob = jax.nn.softmax(g_logits, axis=-1)
    g_sel = jnp.argmax(g_logits, axis=-1).astype(jnp.int32)
    g_w = g_prob[rows, g_sel][:, None]
    e_logits = (hf @ w_er + b_er).astype(jnp.float32).reshape(t_tok, N_GROUPS, EXPERTS_PER_GROUP)
    e_logits = e_logits[rows, g_sel]
    top_v, top_i = lax.top_k(e_logits, TOP_K)
    gate = g_w * jax.nn.softmax(top_v, axis=-1)
    expert_id = g_sel[:, None] * EXPERTS_PER_GROUP + top_i.astype(jnp.int32)
    y = routed_experts(hf, expert_id, gate, w_gate, w_up, w_down)
    return y.reshape(bsz, s, d)


def setup_inputs(seed: int = 0) -> dict:
    key = jax.random.key(seed)
    ks = jax.random.split(key, 24)
    D = D_MODEL

    def nrm(k, shape, scale):
        return jax.random.normal(k, shape, jnp.float32) * scale

    gate_offset = jnp.concatenate([jnp.zeros((2 * D,), jnp.float32), jnp.ones((D,), jnp.float32),
                                   jnp.zeros((2 * D,), jnp.float32), jnp.ones((D,), jnp.float32)])
    return {
        "x": nrm(ks[0], (BATCH, SEQ, D), 1.0),
        "c": nrm(ks[1], (BATCH, D), 1.0),
        "w_ada": nrm(ks[2], (DEPTH, D, 6 * D), 0.25 * D ** -0.5),
        "b_ada": nrm(ks[3], (DEPTH, 6 * D), 0.02) + gate_offset,
        "norm_mix_g": 1.0 + nrm(ks[4], (DEPTH, D), 0.02),
        "norm_ffn_g": 1.0 + nrm(ks[5], (DEPTH, D), 0.02),
        "w_in_even": nrm(ks[6], (N_EVEN, D, IN_COLS), D ** -0.5),
        "sgu_norm_g": 1.0 + nrm(ks[7], (N_EVEN, A_WIDTH), 0.02),
        "w_spatial": nrm(ks[8], (N_EVEN, A_HEADS, CHUNK, CHUNK), CHUNK ** -0.5),
        "b_spatial": 1.0 + nrm(ks[9], (N_EVEN, A_HEADS, CHUNK), 0.02),
        "conv_w": nrm(ks[10], (N_EVEN, CONV_WIDTH, B_WIDTH), CONV_WIDTH ** -0.5),
        "w_out_even": nrm(ks[11], (N_EVEN, MIX_WIDTH, D), MIX_WIDTH ** -0.5),
        "w_pool": nrm(ks[12], (N_ODD, POOL_GROUPS, POOL_GROUP_DIM, POOL_GROUP_DIM), POOL_GROUP_DIM ** -0.5),
        "pool_scale": 1.0 + nrm(ks[13], (N_ODD, D), 0.02),
        "w_group_router": nrm(ks[14], (DEPTH, D, N_GROUPS), D ** -0.5),
        "b_group_router": nrm(ks[15], (DEPTH, N_GROUPS), 0.01),
        "w_expert_router": nrm(ks[16], (DEPTH, D, N_EXPERTS), D ** -0.5),
        "b_expert_router": nrm(ks[17], (DEPTH, N_EXPERTS), 0.01),
        "moe_w_gate": nrm(ks[18], (DEPTH, N_EXPERTS, D, D_EXPERT), D ** -0.5),
        "moe_w_up": nrm(ks[19], (DEPTH, N_EXPERTS, D, D_EXPERT), D ** -0.5),
        "moe_w_down": nrm(ks[20], (DEPTH, N_EXPERTS, D_EXPERT, D), D_EXPERT ** -0.5),
        "final_norm_g": 1.0 + nrm(ks[21], (D,), 0.02),
    }


def reference(x, c, w_ada, b_ada, norm_mix_g, norm_ffn_g, w_in_even, sgu_norm_g,
              w_spatial, b_spatial, conv_w, w_out_even, w_pool, pool_scale,
              w_group_router, b_group_router, w_expert_router, b_expert_router,
              moe_w_gate, moe_w_up, moe_w_down, final_norm_g):
    c_act = jax.nn.silu(c)
    split_pts = [A_WIDTH, 2 * A_WIDTH, 2 * A_WIDTH + B_WIDTH, 2 * A_WIDTH + 2 * B_WIDTH]
    for l in range(DEPTH):
        mod = c_act @ w_ada[l] + b_ada[l]
        sh_m, sc_m, g_m, sh_f, sc_f, g_f = [m[:, None, :] for m in jnp.split(mod, 6, axis=-1)]
        h = rmsnorm(x, norm_mix_g[l]) * (1 + sc_m) + sh_m
        i = l // 2
        if l % 2 == 0:
            z = h @ w_in_even[i]
            u, v, b_gate, c_gate, x_in = jnp.split(z, split_pts, axis=-1)
            y_a = chunk_sgu(u, v, sgu_norm_g[i], w_spatial[i], b_spatial[i])
            y_b = short_gated_conv(b_gate, c_gate, x_in, conv_w[i])
            y = jnp.concatenate([y_a, y_b], axis=-1) @ w_out_even[i]
        else:
            y = pool_mixer(h, w_pool[i], pool_scale[i])
        x = x + g_m * y
        h = rmsnorm(x, norm_ffn_g[l]) * (1 + sc_f) + sh_f
        y = hier_moe(h, w_group_router[l], b_group_router[l], w_expert_router[l],
                     b_expert_router[l], moe_w_gate[l], moe_w_up[l], moe_w_down[l])
        x = x + g_f * y
    return rmsnorm(x, final_norm_g)
```

```cpp
#include <hip/hip_runtime.h>
#include <cstdio>
#include <cstdint>

#ifndef N_LAUNCH_MODE
#define N_LAUNCH_MODE 1
#endif

#ifndef DUP_MASK
#define DUP_MASK 0
#endif
#define NREP(k) (1 + ((DUP_MASK >> (k)) & 1))
#ifndef XCD_LOCAL_SEAMS
#define XCD_LOCAL_SEAMS 1
#endif
#ifndef TAIL_Q1
#define TAIL_Q1 4
#endif
#ifndef TAIL_Q2
#define TAIL_Q2 3
#endif
#define LAS __attribute__((address_space(3)))
typedef _Float16 f16;
typedef _Float16 f16x8 __attribute__((ext_vector_type(8)));
typedef _Float16 f16x4 __attribute__((ext_vector_type(4)));
typedef _Float16 f16x2 __attribute__((ext_vector_type(2)));
typedef float f32x4 __attribute__((ext_vector_type(4)));
typedef unsigned u32x4 __attribute__((ext_vector_type(4)));
typedef unsigned u32x2 __attribute__((ext_vector_type(2)));

constexpr int D = 1024, BATCH = 8, SEQ = 4096, T = BATCH * SEQ, DEPTH = 4;
constexpr int INC = 2560, CHUNK = 128, NE = 32, DE = 512;
constexpr int MAXROWS = 73728;
constexpr float EPS = 1e-6f;
constexpr int SSQ_SLOTS = 16;
constexpr int NWAVES = 8, NTHREADS = 512;

constexpr size_t MiB = 1u << 20;
constexpr size_t WS_CTL = 0, CTL_ZERO_BYTES = 65536;
constexpr size_t WS_MOD = 1 * MiB;
constexpr size_t WS_EID = 2 * MiB;
constexpr size_t WS_GATE = WS_EID + 256 * 1024;
constexpr size_t WS_TOKPOS = WS_GATE + 256 * 1024;
constexpr size_t WS_ROWTOK = WS_TOKPOS + 256 * 1024;
constexpr size_t WS_HIST = 4 * MiB;
constexpr size_t WS_TILE = WS_HIST + 64 * 1024;
constexpr size_t WS_SSQ = 6 * MiB;
constexpr size_t WS_WR = 8 * MiB;
constexpr size_t WS_WSP = 9 * MiB;
constexpr size_t WS_WPOOL = 10 * MiB;
constexpr size_t WS_WOUT = 12 * MiB;
constexpr size_t WS_WIN = 16 * MiB;
constexpr size_t WS_W1 = 32 * MiB;
constexpr size_t WS_W2 = 288 * MiB;
constexpr size_t WS_X = 416 * MiB;
constexpr size_t WS_H = 544 * MiB;
constexpr size_t WS_YCAT = 608 * MiB;
constexpr size_t WS_Z = 672 * MiB;
constexpr size_t WS_ACT = 672 * MiB;
constexpr size_t WS_Y2 = 744 * MiB;
constexpr size_t WS_LIST = 888 * MiB;
constexpr size_t WS_END = 896 * MiB;

constexpr int CW_BAR = 4096;
constexpr int CW_GCNT = 8192;
constexpr int LCAP = 65536;
constexpr int CW_LSUB = 13312, CW_LGEN = 14336;
constexpr int CW_TICKET = 12288;
constexpr int MOE_ITEMS = 32 * 384;

constexpr int LDS_RING = 131072;
constexpr int LDS_TAB = LDS_RING;
constexpr int LDS_MISC = 147456 - 256;
constexpr int LDS_BYTES = 147456;

#define LDS_WAIT() asm volatile("s_waitcnt lgkmcnt(0)" ::: "memory")
__device__ __forceinline__ unsigned pkh(float a, float b) { f16x2 v = {(f16)a, (f16)b}; return __builtin_bit_cast(unsigned, v); }
__device__ __forceinline__ int sidx(int v, int src) { return __builtin_amdgcn_ds_bpermute(src << 2, v); }
__device__ __forceinline__ float sidx(float v, int src) { return __builtin_bit_cast(float, __builtin_amdgcn_ds_bpermute(src << 2, __builtin_bit_cast(int, v))); }
__device__ __forceinline__ float sxor(float v, int m, int lane) { return sidx(v, lane ^ m); }
template <int CTRL> __device__ __forceinline__ float dpp_f_(float v) { return __builtin_bit_cast(float, __builtin_amdgcn_update_dpp(0, __builtin_bit_cast(int, v), CTRL, 0xF, 0xF, true)); }
#define dpp_f(v, ctrl) dpp_f_<ctrl>(v)
__device__ __forceinline__ float wave_sum(float v, int lane) {
#pragma unroll
    for (int o = 1; o < 64; o <<= 1) v += sxor(v, o, lane);
    return v;
}

#define XB_TMO      128
#define XB_XCNT(j)  (256  + 64 * (j))
#define XB_XSUB(j)  (1280 + 64 * (j))
#define XB_XGEN(j)  (2304 + 64 * (j))
#define XB_TOP      3328
#define XB_TOPGEN   3392
#define XCD_BAR_WORDS 3456
#define XB_SPIN_CAP (1u << 18)
__device__ __forceinline__ unsigned xb_ld(unsigned* p)              { return __hip_atomic_load(p, __ATOMIC_RELAXED, __HIP_MEMORY_SCOPE_AGENT); }
__device__ __forceinline__ unsigned xb_add(unsigned* p, unsigned v) { return __hip_atomic_fetch_add(p, v, __ATOMIC_RELAXED, __HIP_MEMORY_SCOPE_AGENT); }
__device__ __forceinline__ unsigned xb_xcc_id() { return (unsigned)__builtin_amdgcn_s_getreg((3 << 11) | 20) & 0xFu; }
#define XB_SPIN(cond, bar) do { unsigned _sp = 0; while (cond) { __builtin_amdgcn_s_sleep(1); \
    if ((++_sp & 255u) == 0u) { if (xb_ld(&(bar)[XB_TMO])) break; if (_sp > XB_SPIN_CAP) { atomicAdd(&(bar)[XB_TMO], 1u); break; } } } } while (0)
struct XcdBarrier { unsigned* bar; unsigned x; volatile LAS unsigned* st; };
__device__ __forceinline__ XcdBarrier xcd_barrier_post(unsigned* bar, volatile LAS unsigned* st) {
    XcdBarrier b; b.bar = bar; b.x = xb_xcc_id(); b.st = st;
    if (threadIdx.x == 0) st[3] = xb_add(&bar[XB_XCNT(b.x)], 1u);
    return b;
}
__device__ __forceinline__ void xcd_barrier_complete(unsigned* bar, unsigned x, unsigned& nloc, unsigned& nx) {
    const unsigned G = gridDim.x * gridDim.y * gridDim.z;
    unsigned sum, cnt, mine, sp = 0u;
    for (;;) {
        sum = 0u; cnt = 0u; mine = 0u;
#pragma unroll
        for (unsigned j = 0; j < 16; ++j) { const unsigned c = xb_ld(&bar[XB_XCNT(j)]); sum += c; cnt += (c > 0u) ? 1u : 0u; mine = (j == x) ? c : mine; }
        if (sum == G) break;
        __builtin_amdgcn_s_sleep(1);
        if ((++sp & 255u) == 0u) { if (xb_ld(&bar[XB_TMO])) break; if (sp > XB_SPIN_CAP) { atomicAdd(&bar[XB_TMO], 1u); break; } }
    }
    nloc = mine > 0u ? mine : 1u; nx = cnt > 0u ? cnt : 1u;
}
__device__ __forceinline__ bool xcd_census_even(unsigned* bar) {
    const unsigned G = gridDim.x; bool ok = (G % 8u) == 0u;
#pragma unroll
    for (unsigned j = 0; j < 16; ++j) { const unsigned c = xb_ld(&bar[XB_XCNT(j)]); ok = ok && (j < 8u ? c == G / 8u : c == 0u); }
    return ok;
}
__device__ __forceinline__ void xcd_local_barrier(unsigned* ctl, unsigned* bar, unsigned x, unsigned nloc, volatile LAS unsigned* st) {
    asm volatile("s_waitcnt vmcnt(0)" ::: "memory");
    __syncthreads();
    if (threadIdx.x == 0) {
        __builtin_amdgcn_s_waitcnt(0);
        const unsigned gen = st[4]; st[4] = gen + 1u;
        const unsigned old = xb_add(&ctl[CW_LSUB + 64 * x], 1u);
        if (old + 1u == (gen + 1u) * nloc) xb_add(&ctl[CW_LGEN + 64 * x], 1u);
        else XB_SPIN(xb_ld(&ctl[CW_LGEN + 64 * x]) == gen, bar);
        __builtin_amdgcn_fence(__ATOMIC_ACQUIRE, "agent");
        asm volatile("s_waitcnt vmcnt(0)" ::: "memory");
    }
    __syncthreads();
}
__device__ __forceinline__ void xcd_barrier(const XcdBarrier& b) {
    asm volatile("s_waitcnt vmcnt(0)" ::: "memory");
    __syncthreads();
    if (threadIdx.x == 0) {
        unsigned* bar = b.bar;
        __builtin_amdgcn_s_waitcnt(0);
        unsigned nloc = b.st[0], nx = b.st[1];
        if (nloc == 0u) { xcd_barrier_complete(bar, b.x, nloc, nx); b.st[0] = nloc; b.st[1] = nx; }
        const unsigned old = xb_add(&bar[XB_XSUB(b.x)], 1u);
        const unsigned gen = old / nloc;
        if (old + 1u == (gen + 1u) * nloc) {
            __builtin_amdgcn_fence(__ATOMIC_RELEASE, "agent");
            asm volatile("s_waitcnt vmcnt(0)" ::: "memory");
            const unsigned og = xb_add(&bar[XB_TOP], 1u);
            const unsigned tg = og / nx;
            if (og + 1u == (tg + 1u) * nx) xb_add(&bar[XB_TOPGEN], 1u);
            else XB_SPIN(xb_ld(&bar[XB_TOPGEN]) == tg, bar);
            __builtin_amdgcn_fence(__ATOMIC_ACQUIRE, "agent");
            xb_add(&bar[XB_XGEN(b.x)], 1u);
            asm volatile("s_waitcnt vmcnt(0)" ::: "memory");
        } else {
            XB_SPIN(xb_ld(&bar[XB_XGEN(b.x)]) == gen, bar);
            __builtin_amdgcn_fence(__ATOMIC_ACQUIRE, "agent");
            asm volatile("s_waitcnt vmcnt(0)" ::: "memory");
        }
    }
    __syncthreads();
}

struct Args { const float* in[22]; float* out; unsigned char* ws; int ph_lo, ph_hi; };
enum { I_X = 0, I_C, I_WADA, I_BADA, I_NMG, I_NFG, I_WIN, I_SGUG, I_WSP, I_BSP, I_CONVW, I_WOUT, I_WPOOL, I_PSCALE,
       I_WGR, I_BGR, I_WER, I_BER, I_MG, I_MU, I_MD, I_FNG };

typedef const __attribute__((address_space(4))) unsigned char* KP;
struct Ctx {
    LAS unsigned char* lds;
    int tid, lane, wave, G, vcu, bidx;
    KP kp;
    unsigned char* ws;
    __device__ __forceinline__ const float* in(int k) const { return *(const float* const __attribute__((address_space(4)))*)(kp + 8 * k); }
    __device__ __forceinline__ float* out() const { return *(float* const __attribute__((address_space(4)))*)(kp + 176); }
};
__device__ __forceinline__ void ctx_refresh(Ctx& X) {
    int t = threadIdx.x; asm volatile("" : "+v"(t)); X.tid = t; X.lane = t & 63; X.wave = __builtin_amdgcn_readfirstlane(t >> 6);
    KP k = (KP)__builtin_amdgcn_kernarg_segment_ptr(); asm volatile("" : "+s"(k)); X.kp = k;
    X.ws = *(unsigned char* const __attribute__((address_space(4)))*)(k + 184);
}
#ifndef WT_STORES
#define WT_STORES 0
#endif
__device__ __forceinline__ void st16(void* p, u32x4 v) {
#if WT_STORES
    asm volatile("global_store_dwordx4 %0, %1, off sc1\n\ts_nop 1" :: "v"(p), "v"(v) : "memory");
#else
    __builtin_nontemporal_store(v, (u32x4*)p);
#endif
}
struct Unit { int arow, acol, brow, orow, ocol, pn, lbase, nvalid; };

struct DenseSched {
    int nM, nN, nwg, G, c; bool acol_pn;
    __device__ void init(int M, int N, int G_, int c_, bool acol_pn_) { nM = M / 256; nN = N / 256; nwg = nM * nN; G = G_; c = c_; acol_pn = acol_pn_; }
    __device__ __forceinline__ bool next(int i, Unit& u) const {
        const long L = (long)i * G + c; if (L >= nwg) return false;
        int wgid = (int)L; { const int q = nwg / 8, r = nwg % 8, xcd = wgid % 8, off = wgid / 8; wgid = (xcd < r ? xcd * (q + 1) : r * (q + 1) + (xcd - r) * q) + off; }
        const int nig = 8 * nN, gid = wgid / nig, fm = gid * 8, gsz = (nM - fm) < 8 ? (nM - fm) : 8;
        const int pm = fm + ((wgid % nig) % gsz), pn = (wgid % nig) / gsz;
        u.arow = pm * 256; u.acol = acol_pn ? pn * 256 : 0; u.brow = pn * 256; u.orow = pm * 256; u.ocol = pn * 256; u.pn = pn; u.lbase = 0; u.nvalid = 0; return true;
    }
};
struct MoeSched {
    const LAS int* tab; int G, vcu, ocol_step; bool lds_list;
    __device__ __forceinline__ bool next(int i, Unit& u) const {
        const int n_rt = __builtin_amdgcn_readfirstlane(tab[64]);
        const int L = i * G + vcu; if (L >= 4 * n_rt) return false;
        const int rt = L >> 2, pn = L & 3; const int e = __builtin_amdgcn_readfirstlane(tab[65 + rt]);
        const int loc = rt * 256 - __builtin_amdgcn_readfirstlane(tab[e]);
        u.arow = rt * 256; u.acol = 0; u.brow = e * 1024 + pn * 256; u.orow = rt * 256; u.ocol = pn * ocol_step; u.pn = pn;
        u.lbase = lds_list ? i * 256 : e * LCAP + loc; u.nvalid = __builtin_amdgcn_readfirstlane(tab[32 + e]) - loc; return true;
    }
};
__device__ __forceinline__ void moe_tables(const Ctx& X, int l) {
    LAS int* tab = (LAS int*)(X.lds + LDS_TAB);
    const int* gcnt = (const int*)(X.ws + WS_CTL) + CW_GCNT + l * 32;
    if (X.tid < 64) {
        const int e = X.lane & 31; const int c = gcnt[e]; const int p = (c + 255) & ~255;
        int incl = p;
#pragma unroll
        for (int o = 1; o < 32; o <<= 1) { const int t = sidx(incl, (X.lane & 32) + ((e - o) & 31)); if (e >= o) incl += t; }
        const int st = incl - p;
        if (X.lane < 32) { tab[e] = st; tab[32 + e] = c; if (e == 31) tab[64] = incl >> 8; for (int rt = st >> 8; rt < (incl >> 8); ++rt) tab[65 + rt] = e; }
    }
    __syncthreads();
}
struct EpiStoreF16 {
    static constexpr bool ROWSUM = false, PERM = true, PRELOAD = false;
    f16* O; int ldo;
    __device__ __forceinline__ float store8(const Unit& u, int r, int c, f32x4 v0, f32x4 v1) const {
        u32x4 w; w.x = pkh(v0[0], v0[1]); w.y = pkh(v0[2], v0[3]); w.z = pkh(v1[0], v1[1]); w.w = pkh(v1[2], v1[3]);
        st16(O + (size_t)(u.orow + r) * ldo + u.ocol + c, w); return 0.f;
    }
    __device__ __forceinline__ void dual8(const Unit&, int, int, f32x4, f32x4, f32x4, f32x4) const {}
    __device__ __forceinline__ float operator()(const Unit& u, int r, int c, f32x4 v) const {
        u32x2 w; w.x = pkh(v[0], v[1]); w.y = pkh(v[2], v[3]);
        *(u32x2*)(O + (size_t)(u.orow + r) * ldo + u.ocol + c) = w; return 0.f;
    }
    __device__ __forceinline__ void dual(const Unit&, int, int, f32x4, f32x4) const {}
    __device__ __forceinline__ void rowsum(const Unit&, int, int, float) const {}
};
struct EpiResid {
    static constexpr bool ROWSUM = true, PERM = true, PRELOAD = true;
    f16* Xh; const float* gm  ; const float* ps; float* ssq;
    typedef f16x8 Pre;
    struct Scale { f32x4 s0, s1; };
    __device__ __forceinline__ Scale scale8(const Unit& u, int c) const {
        const int col = u.ocol + c, b = u.orow >> 12; Scale S;
        S.s0 = *(const f32x4*)(gm + (size_t)b * 6144 + col); S.s1 = *(const f32x4*)(gm + (size_t)b * 6144 + col + 4);
        if (ps) { S.s0 = S.s0 * *(const f32x4*)(ps + col); S.s1 = S.s1 * *(const f32x4*)(ps + col + 4); }
        return S;
    }
    __device__ __forceinline__ Pre load8(const Unit& u, int r, int c) const { return *(const f16x8*)(Xh + (size_t)(u.orow + r) * D + u.ocol + c); }
    __device__ __forceinline__ float store8p(const Unit& u, int r, int c, f32x4 v0, f32x4 v1, const Pre& P, const Scale& S) const {
        const int row = u.orow + r, col = u.ocol + c;
        f32x4 x0, x1;
#pragma unroll
        for (int j = 0; j < 4; ++j) { x0[j] = (float)P[j]; x1[j] = (float)P[4 + j]; }
        x0 = x0 + S.s0 * v0; x1 = x1 + S.s1 * v1;
        u32x4 w; w.x = pkh(x0[0], x0[1]); w.y = pkh(x0[2], x0[3]); w.z = pkh(x1[0], x1[1]); w.w = pkh(x1[2], x1[3]);
        st16(Xh + (size_t)row * D + col, w);
        return ((x0[0] * x0[0] + x0[1] * x0[1]) + (x0[2] * x0[2] + x0[3] * x0[3])) + ((x1[0] * x1[0] + x1[1] * x1[1]) + (x1[2] * x1[2] + x1[3] * x1[3]));
    }
    __device__ __forceinline__ float store8(const Unit&, int, int, f32x4, f32x4) const { return 0.f; }
    __device__ __forceinline__ void dual8(const Unit&, int, int, f32x4, f32x4, f32x4, f32x4) const {}
    __device__ __forceinline__ float operator()(const Unit&, int, int, f32x4) const { return 0.f; }
    __device__ __forceinline__ void dual(const Unit&, int, int, f32x4, f32x4) const {}
    __device__ __forceinline__ void rowsum(const Unit& u, int r, int wc, float s) const { ssq[(size_t)(u.orow + r) * SSQ_SLOTS + u.pn * 4 + wc] = s; }
};
struct EpiSiluMul {
    static constexpr bool ROWSUM = false, PERM = true, PRELOAD = false;
    f16* O;
    __device__ __forceinline__ float store8(const Unit&, int, int, f32x4, f32x4) const { return 0.f; }
    __device__ __forceinline__ void dual8(const Unit& u, int r, int c, f32x4 g0, f32x4 g1, f32x4 u0, f32x4 u1) const {
        float o[8];
#pragma unroll
        for (int j = 0; j < 4; ++j) { const float a0 = g0[j], a1 = g1[j];
            o[j] = a0 * __builtin_amdgcn_rcpf(1.f + __builtin_amdgcn_exp2f(-1.44269504f * a0)) * u0[j]; o[4 + j] = a1 * __builtin_amdgcn_rcpf(1.f + __builtin_amdgcn_exp2f(-1.44269504f * a1)) * u1[j]; }
        u32x4 w; w.x = pkh(o[0], o[1]); w.y = pkh(o[2], o[3]); w.z = pkh(o[4], o[5]); w.w = pkh(o[6], o[7]);
        st16(O + (size_t)(u.orow + r) * DE + u.ocol + c, w);
    }
    __device__ __forceinline__ float operator()(const Unit&, int, int, f32x4) const { return 0.f; }
    __device__ __forceinline__ void dual(const Unit& u, int r, int c, f32x4 g, f32x4 up) const {
        float o[4];
#pragma unroll
        for (int j = 0; j < 4; ++j) { const float a = g[j]; o[j] = a / (1.f + __expf(-a)) * up[j]; }
        u32x2 w; w.x = pkh(o[0], o[1]); w.y = pkh(o[2], o[3]);
        *(u32x2*)(O + (size_t)(u.orow + r) * DE + u.ocol + c) = w;
    }
    __device__ __forceinline__ void rowsum(const Unit&, int, int, float) const {}
};

__device__ __forceinline__ int lds_byte(int r, int c) { const int st = (r >> 4) * 2 + (c >> 5), rr = r & 15, cc = c & 31, ob = rr * 64 + cc * 2; return st * 1024 + (ob ^ (((ob >> 9) & 1) << 5)); }
__device__ __forceinline__ void stage_rc(int b, int& R, int& C) { const int st = b / 1024, sb = b % 1024, swz = sb ^ (((sb >> 9) & 1) << 5); R = (st >> 1) * 16 + swz / 64; C = (st & 1) * 32 + (swz % 64) / 2; }
constexpr int HTB = 128 * 64 * 2;
template <class Epi, class Sched, bool GATHER, bool DUAL>
__device__ __forceinline__ void gemm8(LAS unsigned char* lds, const f16* A, const int lda, const f16* Bt, const int K, const LAS int* ltok, const Sched& S, const Epi& E) {
    int tz = threadIdx.x; asm volatile("" : "+v"(tz));
    const int tid = tz, wid = __builtin_amdgcn_readfirstlane(tid >> 6), lane = tid & 63, wr = wid >> 2, wc = wid & 3, fr = lane & 15, fq = lane >> 4;
    const int nt = K / 64;
    unsigned voffB[2];
#pragma unroll
    for (int i = 0; i < 2; ++i) { int R_, C_; stage_rc(tid * 16 + i * 8192, R_, C_); int Rb = R_;
        if (Epi::PERM) { const int rho = R_ & 31, pn_ = rho >> 4, pi_ = rho & 15; Rb = (R_ & ~31) + 8 * (pi_ >> 2) + 4 * pn_ + (pi_ & 3); }
        voffB[i] = (unsigned)(Rb * K + C_) * 2u; }
    const size_t kstep = 128;
    const size_t hstepB = (size_t)128 * K * 2;
    const unsigned ldsw = (unsigned)wid * 1024u;
    const int aoff = lds_byte(wr * 64 + fr, fq * 8), boff = lds_byte(wc * 32 + fr, fq * 8);
#define G8_SA(b, h) (((b) * 2 + (h)) * HTB)
#define G8_SB(b, h) ((4 + (b) * 2 + (h)) * HTB)
#define G8_STAGE(bufoff, gbase, voff) do { _Pragma("unroll") for (int _i = 0; _i < 2; ++_i) \
        __builtin_amdgcn_global_load_lds((const unsigned*)((const char*)(gbase) + (voff)[_i]), (LAS unsigned*)(lds + (bufoff) + ldsw + _i * 8192), 16, 0, 0); } while (0)
#define G8_LDA(dst, b, h) do { _Pragma("unroll") for (int m = 0; m < 4; ++m) _Pragma("unroll") for (int k = 0; k < 2; ++k) dst[m][k] = *(const LAS f16x8*)(lds + G8_SA(b, h) + aoff + m * 2048 + k * 1024); } while (0)
#define G8_LDB(dst, b, h) do { _Pragma("unroll") for (int n = 0; n < 2; ++n) _Pragma("unroll") for (int k = 0; k < 2; ++k) dst[n][k] = *(const LAS f16x8*)(lds + G8_SB(b, h) + boff + n * 2048 + k * 1024); } while (0)
#define G8_MMA(ai, bj, At, Bt_) do { __builtin_amdgcn_s_setprio(1); _Pragma("unroll") for (int m = 0; m < 4; ++m) _Pragma("unroll") for (int n = 0; n < 2; ++n) _Pragma("unroll") for (int k = 0; k < 2; ++k) \
        acc[ai][bj][m][n] = __builtin_amdgcn_mfma_f32_16x16x32_f16(Bt_[n][k], At[m][k], acc[ai][bj][m][n], 0, 0, 0); __builtin_amdgcn_s_setprio(0); } while (0)
#define G8_WAIT_V(n) asm volatile("s_waitcnt vmcnt(" #n ")" ::: "memory")
#define G8_WAIT_L(n) asm volatile("s_waitcnt lgkmcnt(" #n ")" ::: "memory")
#define G8_BAR __builtin_amdgcn_s_barrier()
#define G8_SCHED __builtin_amdgcn_sched_barrier(0)
#define G8_VOFFA(vo, u) do { _Pragma("unroll") for (int _h = 0; _h < 2; ++_h) _Pragma("unroll") for (int _i = 0; _i < 2; ++_i) { int _R, _C; stage_rc(tid * 16 + _i * 8192, _R, _C); const int _idx = _h * 128 + _R; \
        const int _g = GATHER ? ltok[(u).lbase + _idx] : (u).arow + _idx; (vo)[_h][_i] = (unsigned)(_g * lda + _C) * 2u; } \
        asm volatile("" : "+v"((vo)[0][0]), "+v"((vo)[0][1]), "+v"((vo)[1][0]), "+v"((vo)[1][1])); } while (0)
    Unit cur, nxt; int ui = 0;
    if (!S.next(0, cur)) return;
    f32x4 acc[2][2][4][2];
#pragma unroll
    for (int a = 0; a < 2; ++a)
#pragma unroll
        for (int b = 0; b < 2; ++b)
#pragma unroll
            for (int m = 0; m < 4; ++m)
#pragma unroll
                for (int n = 0; n < 2; ++n) acc[a][b][m][n] = (f32x4){0.f, 0.f, 0.f, 0.f};
    f16x8 At[4][2], B0[2][2], B1[2][2];
    unsigned voffA[2][2], nvoffA[2][2];
    G8_VOFFA(voffA, cur);
    const char* cA = (const char*)A + (size_t)cur.acol * 2; const char* cB = (const char*)Bt + (size_t)cur.brow * K * 2;
    G8_STAGE(G8_SB(0, 0), cB, voffB); G8_STAGE(G8_SB(0, 1), cB + hstepB, voffB); G8_STAGE(G8_SA(0, 0), cA, voffA[0]); G8_STAGE(G8_SA(0, 1), cA, voffA[1]);
    if (wr == 1) G8_BAR;
    G8_WAIT_V(2); G8_BAR;
    G8_STAGE(G8_SB(1, 0), cB + kstep, voffB); G8_STAGE(G8_SA(1, 0), cA + kstep, voffA[0]); G8_STAGE(G8_SB(1, 1), cB + hstepB + kstep, voffB);
    G8_WAIT_V(6); G8_BAR;
    for (;;) {
        const bool has_next = S.next(ui + 1, nxt);
        const char* nA = cA; const char* nB = cB;
        if (has_next) { G8_VOFFA(nvoffA, nxt); nA = (const char*)A + (size_t)nxt.acol * 2; nB = (const char*)Bt + (size_t)nxt.brow * K * 2; }
        else {
#pragma unroll
            for (int h = 0; h < 2; ++h)
#pragma unroll
                for (int i = 0; i < 2; ++i) nvoffA[h][i] = voffA[h][i];
        }
        for (int t = 0; t < nt; t += 2) {
            const bool last = (t == nt - 2);
            const char* a1 = cA + (size_t)(t + 1) * kstep;
            const char* a2 = last ? nA : cA + (size_t)(t + 2) * kstep; const char* b2 = last ? nB : cB + (size_t)(t + 2) * kstep;
            const char* a3 = a2 + kstep; const char* b3 = b2 + kstep;
            unsigned v2[2][2];
#pragma unroll
            for (int h = 0; h < 2; ++h)
#pragma unroll
                for (int i = 0; i < 2; ++i) v2[h][i] = last ? nvoffA[h][i] : voffA[h][i];
            G8_LDB(B0, 0, 0); G8_LDB(B1, 0, 1); G8_SCHED; G8_LDA(At, 0, 0); G8_STAGE(G8_SA(1, 1), a1, voffA[1]);
            G8_WAIT_V(8); G8_WAIT_L(0); G8_BAR; G8_MMA(0, 0, At, B0); G8_MMA(0, 1, At, B1); G8_BAR; G8_SCHED;
            G8_LDA(At, 0, 1); G8_STAGE(G8_SB(0, 0), b2, voffB); G8_STAGE(G8_SB(0, 1), b2 + hstepB, voffB); G8_STAGE(G8_SA(0, 0), a2, v2[0]);
            G8_WAIT_V(8); G8_WAIT_L(0); G8_BAR; G8_MMA(1, 0, At, B0); G8_MMA(1, 1, At, B1); G8_BAR; G8_SCHED;
            G8_LDB(B0, 1, 0); G8_LDB(B1, 1, 1); G8_SCHED; G8_LDA(At, 1, 0); G8_STAGE(G8_SA(0, 1), a2, v2[1]);
            G8_WAIT_V(8); G8_WAIT_L(0); G8_BAR; G8_MMA(0, 0, At, B0); G8_MMA(0, 1, At, B1); G8_BAR; G8_SCHED;
            G8_LDA(At, 1, 1); G8_STAGE(G8_SB(1, 0), b3, voffB); G8_STAGE(G8_SB(1, 1), b3 + hstepB, voffB); G8_STAGE(G8_SA(1, 0), a3, v2[0]);
            G8_WAIT_V(8); G8_WAIT_L(0); G8_BAR; G8_MMA(1, 0, At, B0); G8_MMA(1, 1, At, B1); G8_BAR; G8_SCHED;
        }
        if (wr == 0) G8_BAR;
        if constexpr (Epi::PRELOAD) {
            typename Epi::Scale SC[2];
#pragma unroll
            for (int bj = 0; bj < 2; ++bj) SC[bj] = E.scale8(cur, bj * 128 + wc * 32 + fq * 8);
#pragma unroll
            for (int ai = 0; ai < 2; ++ai) {
                typename Epi::Pre PR[4][2];
#pragma unroll
                for (int m = 0; m < 4; ++m)
#pragma unroll
                    for (int bj = 0; bj < 2; ++bj) PR[m][bj] = E.load8(cur, ai * 128 + wr * 64 + m * 16 + fr, bj * 128 + wc * 32 + fq * 8);
#pragma unroll
                for (int m = 0; m < 4; ++m) {
                    const int r = ai * 128 + wr * 64 + m * 16 + fr; float ss = 0.f;
#pragma unroll
                    for (int bj = 0; bj < 2; ++bj) ss += E.store8p(cur, r, bj * 128 + wc * 32 + fq * 8, acc[ai][bj][m][0], acc[ai][bj][m][1], PR[m][bj], SC[bj]);
                    ss += sxor(ss, 16, lane); ss += sxor(ss, 32, lane); if (fq == 0) E.rowsum(cur, r, wc, ss);
                }
            }
        } else {
#pragma unroll
        for (int ai = 0; ai < 2; ++ai)
#pragma unroll
            for (int m = 0; m < 4; ++m) {
                const int r = ai * 128 + wr * 64 + m * 16 + fr; float ss = 0.f;
                if (Epi::PERM) {
                    if (!DUAL) {
#pragma unroll
                        for (int bj = 0; bj < 2; ++bj) ss += E.store8(cur, r, bj * 128 + wc * 32 + fq * 8, acc[ai][bj][m][0], acc[ai][bj][m][1]);
                    } else E.dual8(cur, r, wc * 32 + fq * 8, acc[ai][0][m][0], acc[ai][0][m][1], acc[ai][1][m][0], acc[ai][1][m][1]);
                } else if (!DUAL) {
#pragma unroll
                    for (int bj = 0; bj < 2; ++bj)
#pragma unroll
                        for (int n = 0; n < 2; ++n) ss += E(cur, r, bj * 128 + wc * 32 + n * 16 + fq * 4, acc[ai][bj][m][n]);
                } else {
#pragma unroll
                    for (int n = 0; n < 2; ++n) E.dual(cur, r, wc * 32 + n * 16 + fq * 4, acc[ai][0][m][n], acc[ai][1][m][n]);
                }
                if (Epi::ROWSUM) { ss += sxor(ss, 16, lane); ss += sxor(ss, 32, lane); if (fq == 0) E.rowsum(cur, r, wc, ss); }
            }
        }
        if (!has_next) break;
#pragma unroll
        for (int a = 0; a < 2; ++a)
#pragma unroll
            for (int b = 0; b < 2; ++b)
#pragma unroll
                for (int m = 0; m < 4; ++m)
#pragma unroll
                    for (int n = 0; n < 2; ++n) acc[a][b][m][n] = (f32x4){0.f, 0.f, 0.f, 0.f};
        cur = nxt; cA = nA; cB = nB; ++ui;
#pragma unroll
        for (int h = 0; h < 2; ++h)
#pragma unroll
            for (int i = 0; i < 2; ++i) voffA[h][i] = nvoffA[h][i];
        if (wr == 1) G8_BAR;
    }
    G8_WAIT_V(0);
    G8_BAR;
#undef G8_SA
#undef G8_SB
#undef G8_STAGE
#undef G8_LDA
#undef G8_LDB
#undef G8_MMA
#undef G8_WAIT_V
#undef G8_WAIT_L
#undef G8_BAR
#undef G8_SCHED
#undef G8_VOFFA
}

template <class Sched, class Epi, bool GATHER, bool DUAL>
__device__ __forceinline__ void run_gemm(const Ctx& X, const f16* A, int lda, const f16* Bt, int K, const LAS int* ltok, const Sched& S, const Epi& E) {
    gemm8<Epi, Sched, GATHER, DUAL>(X.lds, A, lda, Bt, K, ltok, S, E);
}

constexpr int TR_TILE_BYTES = 64 * 65 * 4;
__device__ __forceinline__ void tr_item(const float* W, int K, int N, f16* WT, int ldd, int mapmode, LAS float* scr, int item, int lane) {
    const int nblk = N / 64, kb = item / nblk, nb = item % nblk, k0 = 64 * kb, n0 = 64 * nb;
    const int c16 = lane & 15, kr = lane >> 4;
    f32x4 v[16];
#pragma unroll
    for (int i = 0; i < 16; ++i) v[i] = *(const f32x4*)(W + (size_t)(k0 + 4 * i + kr) * N + n0 + 4 * c16);
#pragma unroll
    for (int i = 0; i < 16; ++i) { LAS float* d = scr + (4 * i + kr) * 65 + 4 * c16; d[0] = v[i][0]; d[1] = v[i][1]; d[2] = v[i][2]; d[3] = v[i][3]; }
    LDS_WAIT(); asm volatile("" ::: "memory");
    const int c = lane & 7;
#pragma unroll
    for (int j = 0; j < 8; ++j) {
        const int nl = (lane >> 3) + 8 * j, n = n0 + nl; const LAS float* s = scr + (8 * c) * 65 + nl;
        u32x4 o; o.x = pkh(s[0 * 65], s[1 * 65]); o.y = pkh(s[2 * 65], s[3 * 65]); o.z = pkh(s[4 * 65], s[5 * 65]); o.w = pkh(s[6 * 65], s[7 * 65]);
        int drow = n;
        if (mapmode == 1) drow = 256 * (n >> 7) + (n & 127);
        else if (mapmode == 2) drow = 256 * (n >> 7) + (n & 127) + 128;
        *(u32x4*)(WT + (size_t)drow * ldd + k0 + 8 * c) = o;
    }
    LDS_WAIT(); asm volatile("" ::: "memory");
}

__device__ __forceinline__ void mod_item(const Ctx& X, int item) {
    LAS float* cact = (LAS float*)X.lds;
    LAS float* red = (LAS float*)(X.lds + 32768);
    const float* c = X.in(I_C); const float* w_ada = X.in(I_WADA); const float* b_ada = X.in(I_BADA);
    float* mod = (float*)(X.ws + WS_MOD);
    const int l = item / 48, jc = item % 48;
    for (int i = X.tid; i < 8192; i += NTHREADS) { const int b = i >> 10, k = i & 1023; const float v = c[b * 1024 + k]; cact[k * 8 + b] = v / (1.f + expf(-v)); }
    __syncthreads();
    const int c4 = X.lane & 31, ks = X.lane >> 5;
    const float* wp = w_ada + (size_t)l * 1024 * 6144 + jc * 128 + c4 * 4;
    f32x4 acc[8];
#pragma unroll
    for (int b = 0; b < 8; ++b) acc[b] = (f32x4){0.f, 0.f, 0.f, 0.f};
    const float* pw = wp + (size_t)(X.wave * 128 + ks) * 6144;
    f32x4 wa[8], wb[8];
#pragma unroll
    for (int u = 0; u < 8; ++u) wa[u] = *(const f32x4*)(pw + (size_t)u * 12288);
#pragma unroll 1
    for (int kb = 0; kb < 64; kb += 16) {
        const float* pb = pw + (size_t)(kb + 8) * 12288;
#pragma unroll
        for (int u = 0; u < 8; ++u) wb[u] = *(const f32x4*)(pb + (size_t)u * 12288);
#pragma unroll
        for (int u = 0; u < 8; ++u) {
            const int k = X.wave * 128 + 2 * (kb + u) + ks; const f32x4 w = wa[u];
            const f32x4 c0 = *(const LAS f32x4*)(cact + k * 8), c1 = *(const LAS f32x4*)(cact + k * 8 + 4);
            acc[0] += c0[0] * w; acc[1] += c0[1] * w; acc[2] += c0[2] * w; acc[3] += c0[3] * w;
            acc[4] += c1[0] * w; acc[5] += c1[1] * w; acc[6] += c1[2] * w; acc[7] += c1[3] * w;
        }
        const float* pa = pw + (size_t)((kb + 16 < 64) ? kb + 16 : kb) * 12288;
#pragma unroll
        for (int u = 0; u < 8; ++u) wa[u] = *(const f32x4*)(pa + (size_t)u * 12288);
#pragma unroll
        for (int u = 0; u < 8; ++u) {
            const int k = X.wave * 128 + 2 * (kb + 8 + u) + ks; const f32x4 w = wb[u];
            const f32x4 c0 = *(const LAS f32x4*)(cact + k * 8), c1 = *(const LAS f32x4*)(cact + k * 8 + 4);
            acc[0] += c0[0] * w; acc[1] += c0[1] * w; acc[2] += c0[2] * w; acc[3] += c0[3] * w;
            acc[4] += c1[0] * w; acc[5] += c1[1] * w; acc[6] += c1[2] * w; acc[7] += c1[3] * w;
        }
    }
#pragma unroll
    for (int b = 0; b < 8; ++b)
#pragma unroll
        for (int j = 0; j < 4; ++j) acc[b][j] += sxor(acc[b][j], 32, X.lane);
    if (X.lane < 32) {
#pragma unroll
        for (int b = 0; b < 8; ++b) *(LAS f32x4*)(red + (X.wave * 8 + b) * 128 + c4 * 4) = acc[b];
    }
    __syncthreads();
    for (int o = X.tid; o < 1024; o += NTHREADS) {
        const int b = o >> 7, col = o & 127; float s = b_ada[l * 6144 + jc * 128 + col];
#pragma unroll
        for (int w = 0; w < 8; ++w) s += red[(w * 8 + b) * 128 + col];
        mod[(size_t)(l * 8 + b) * 6144 + jc * 128 + col] = s;
    }
    __syncthreads();
}

__device__ __forceinline__ void moe_item(const Ctx& X, int L, int it, LAS float* scr) {
    f16* W1 = (f16*)(X.ws + WS_W1); f16* W2 = (f16*)(X.ws + WS_W2);
    const int le = L * 32 + it / 384, q = it % 384, which = q >> 7, item = q & 127;
    if (which == 0) tr_item(X.in(I_MG) + (size_t)le * D * DE, D, DE, W1 + (size_t)le * 1024 * 1024, D, 1, scr, item, X.lane);
    else if (which == 1) tr_item(X.in(I_MU) + (size_t)le * D * DE, D, DE, W1 + (size_t)le * 1024 * 1024, D, 2, scr, item, X.lane);
    else tr_item(X.in(I_MD) + (size_t)le * DE * D, DE, D, W2 + (size_t)le * 1024 * 512, DE, 0, scr, item, X.lane);
}
__device__ __forceinline__ void moe_convert_batches(const Ctx& X, int L, int max_batches) {
    LAS int* slot = (LAS int*)(X.lds + LDS_MISC + 64);
    unsigned* ticket = (unsigned*)(X.ws + WS_CTL) + CW_TICKET + L * 64;
    LAS float* scr = (LAS float*)(X.lds + X.wave * TR_TILE_BYTES);
    for (int b = 0; b < max_batches; ++b) {
        __syncthreads();
        if (X.tid == 0) *slot = (int)atomicAdd(ticket, 8u);
        __syncthreads();
        const int base = *slot;
        if (base >= MOE_ITEMS) break;
        moe_item(X, L, base + X.wave, scr);
    }
    __syncthreads();
}
__device__ __forceinline__ void p0_prologue(const Ctx& X) {
    __syncthreads();
    for (int it = X.vcu; it < 192; it += X.G) mod_item(X, it);
    LAS float* scr = (LAS float*)(X.lds + X.wave * TR_TILE_BYTES);
    const int gw = X.vcu * NWAVES + X.wave, NGW = X.G * NWAVES;
    f16* WIN = (f16*)(X.ws + WS_WIN); f16* WOUT = (f16*)(X.ws + WS_WOUT); f16* WPOOL = (f16*)(X.ws + WS_WPOOL);
    constexpr int N_IN = 2 * 640, N_OUT = 2 * 256, N_POOL = 8 * 16;
    for (int it = gw; it < N_IN + N_OUT + N_POOL; it += NGW) {
        int r = it;
        if (r < N_IN) { const int i = r / 640, q = r % 640; tr_item(X.in(I_WIN) + (size_t)i * D * INC, D, INC, WIN + (size_t)i * INC * D, D, 0, scr, q, X.lane); continue; } r -= N_IN;
        if (r < N_OUT) { const int i = r / 256, q = r % 256; tr_item(X.in(I_WOUT) + (size_t)i * D * D, D, D, WOUT + (size_t)i * D * D, D, 0, scr, q, X.lane); continue; } r -= N_OUT;
        { const int ig = r / 16, q = r % 16; tr_item(X.in(I_WPOOL) + (size_t)ig * 256 * 256, 256, 256, WPOOL + (size_t)ig * 256 * 256, 256, 0, scr, q, X.lane); }
    }
    {
        f16* WR = (f16*)(X.ws + WS_WR);
        const size_t gt = (size_t)X.vcu * NTHREADS + X.tid, NGT = (size_t)X.G * NTHREADS;
        for (size_t idx = gt; idx < (size_t)4 * 32 * 3 * 2 * 64 * 8; idx += NGT) {
            const int jj = (int)(idx & 7), ln = (int)((idx >> 3) & 63), hl = (int)((idx >> 9) & 1); const int r3 = (int)(idx >> 10);
            const int nb = r3 % 3, s = (r3 / 3) & 31, l = r3 / 96;
            const int col = 16 * nb + (ln & 15), k = 32 * s + 8 * (ln >> 4) + jj;
            float w = 0.f;
            if (col < 4) w = X.in(I_WGR)[((size_t)l * D + k) * 4 + col]; else if (col < 36) w = X.in(I_WER)[((size_t)l * D + k) * 32 + col - 4];
            w *= 1024.f; const f16 hi = (f16)w; const f16 lo = (f16)(w - (float)hi);
            WR[idx] = hl ? lo : hi;
        }
    }
    {
        f16* WSP = (f16*)(X.ws + WS_WSP); const float* wsp = X.in(I_WSP);
        const size_t gt = (size_t)X.vcu * NTHREADS + X.tid, NGT = (size_t)X.G * NTHREADS;
        for (size_t i = gt; i < (size_t)2 * 8 * 128 * 128; i += NGT) { const int s = (int)(i & 127), t = (int)((i >> 7) & 127); WSP[i] = (f16)(s <= t ? wsp[i] : 0.f); }
    }
    moe_convert_batches(X, 0, 1 << 30);
}

struct NormRow { f32x4 x[4]; f16x4 xh[4], y0[4], y1[4]; };
template <int MODE>
__device__ __forceinline__ void norm_load(NormRow& R, const float* xsrc, const f16* Xh, const f16* Y2, int row, int lane, int p0, int p1) {
    if (MODE == 0) {
#pragma unroll
        for (int j = 0; j < 4; ++j) R.x[j] = *(const f32x4*)(xsrc + (size_t)row * D + 4 * lane + 256 * j);
    } else {
#pragma unroll
        for (int j = 0; j < 4; ++j) R.xh[j] = *(const f16x4*)(Xh + (size_t)row * D + 4 * lane + 256 * j);
    }
    if (MODE != 0) {
#pragma unroll
        for (int j = 0; j < 4; ++j) { R.y0[j] = *(const f16x4*)(Y2 + (size_t)p0 * D + 4 * lane + 256 * j); R.y1[j] = *(const f16x4*)(Y2 + (size_t)p1 * D + 4 * lane + 256 * j); }
    }
}
template <int MODE>
__device__ __forceinline__ void norm_phase(const Ctx& X, int l) {
    const float* mod = (const float*)(X.ws + WS_MOD);
    f16* Xb = (f16*)(X.ws + WS_X); f16* H = (f16*)(X.ws + WS_H);
    const f16* Y2 = (const f16*)(X.ws + WS_Y2);
    const int* tokpos = (const int*)(X.ws + WS_TOKPOS); const float* gate = (const float*)(X.ws + WS_GATE); const int* eid = (const int*)(X.ws + WS_EID);
    const int* gcnt = (const int*)(X.ws + WS_CTL) + CW_GCNT + (l - 1) * 32;
    const float* xsrc = X.in(I_X);
    const int gw = X.vcu * NWAVES + X.wave, NGW = X.G * NWAVES;
    for (int r0 = gw * 16; r0 < T; r0 += NGW * 16) {
        const int b = r0 >> 12;
        int tp = 0; float gt = 0.f;
        if (MODE != 0) {
            const int e = X.lane & 31; const int c = gcnt[e]; const int p = (c + 255) & ~255;
            int incl = p;
#pragma unroll
            for (int o = 1; o < 32; o <<= 1) { const int t = sidx(incl, (X.lane & 32) + ((e - o) & 31)); if (e >= o) incl += t; }
            const int pst = incl - p;
            int ee = 0, rk = 0;
            if (X.lane < 32) { ee = eid[r0 * 2 + X.lane]; rk = tokpos[r0 * 2 + X.lane]; gt = gate[r0 * 2 + X.lane]; }
            tp = sidx(pst, ee) + rk;
        }
        f32x4 A[4], S[4], GF[4];
#pragma unroll
        for (int j = 0; j < 4; ++j) {
            const int c = 4 * X.lane + 256 * j;
            if (MODE == 2) { A[j] = *(const f32x4*)(X.in(I_FNG) + c); S[j] = (f32x4){0.f, 0.f, 0.f, 0.f}; }
            else { const float* ml = mod + (size_t)(l * 8 + b) * 6144;
                   A[j] = *(const f32x4*)(X.in(I_NMG) + l * D + c) * (*(const f32x4*)(ml + 1024 + c) + 1.0f); S[j] = *(const f32x4*)(ml + c); }
            if (MODE != 0) GF[j] = *(const f32x4*)(mod + (size_t)((l - 1) * 8 + b) * 6144 + 5120 + c);
        }
        NormRow cur, nxt, nx2;
        norm_load<MODE>(cur, xsrc, Xb, Y2, r0, X.lane, sidx(tp, 0), sidx(tp, 1));
        norm_load<MODE>(nxt, xsrc, Xb, Y2, r0 + 1, X.lane, sidx(tp, 2), sidx(tp, 3));
#pragma unroll
        for (int rr = 0; rr < 16; ++rr) {
            const int row = r0 + rr;
            if (rr + 2 < 16) norm_load<MODE>(nx2, xsrc, Xb, Y2, row + 2, X.lane, sidx(tp, 2 * rr + 4), sidx(tp, 2 * rr + 5));
            f32x4 x[4];
#pragma unroll
            for (int j = 0; j < 4; ++j) { if (MODE == 0) x[j] = cur.x[j]; else { x[j][0] = (float)cur.xh[j][0]; x[j][1] = (float)cur.xh[j][1]; x[j][2] = (float)cur.xh[j][2]; x[j][3] = (float)cur.xh[j][3]; } }
            if (MODE != 0) {
                const float g0 = sidx(gt, 2 * rr), g1 = sidx(gt, 2 * rr + 1);
#pragma unroll
                for (int j = 0; j < 4; ++j) {
                    const f16x4 y0 = cur.y0[j], y1 = cur.y1[j];
                    f32x4 y; y[0] = g0 * (float)y0[0] + g1 * (float)y1[0]; y[1] = g0 * (float)y0[1] + g1 * (float)y1[1]; y[2] = g0 * (float)y0[2] + g1 * (float)y1[2]; y[3] = g0 * (float)y0[3] + g1 * (float)y1[3];
                    x[j] = x[j] + GF[j] * y;
                    if (MODE == 1) { u32x2 w; w.x = pkh(x[j][0], x[j][1]); w.y = pkh(x[j][2], x[j][3]); *(u32x2*)(Xb + (size_t)row * D + 4 * X.lane + 256 * j) = w; }
                }
            }
            if (MODE == 0) {
#pragma unroll
                for (int j = 0; j < 4; ++j) { u32x2 w; w.x = pkh(x[j][0], x[j][1]); w.y = pkh(x[j][2], x[j][3]); *(u32x2*)(Xb + (size_t)row * D + 4 * X.lane + 256 * j) = w; }
            }
            float s = 0.f;
#pragma unroll
            for (int j = 0; j < 4; ++j) s += (x[j][0] * x[j][0] + x[j][1] * x[j][1]) + (x[j][2] * x[j][2] + x[j][3] * x[j][3]);
            const float rstd = 1.0f / sqrtf(wave_sum(s, X.lane) * (1.f / D) + EPS);
#pragma unroll
            for (int j = 0; j < 4; ++j) {
                const f32x4 h = x[j] * rstd * A[j] + S[j];
                if (MODE == 2) *(f32x4*)(X.out() + (size_t)row * D + 4 * X.lane + 256 * j) = h;
                else { u32x2 w; w.x = pkh(h[0], h[1]); w.y = pkh(h[2], h[3]); *(u32x2*)(H + (size_t)row * D + 4 * X.lane + 256 * j) = w; }
            }
            cur = nxt; nxt = nx2;
        }
    }
}

__device__ __forceinline__ void route_token(const LAS float* L, int row, int* eid, float* gate, LAS int* hist, LAS int* le, LAS int* lr, bool writer) {
    int gs = 0; float gm = L[0];
#pragma unroll
    for (int i = 1; i < 4; ++i) { const float v = L[i]; if (v > gm) { gm = v; gs = i; } }
    float den = 0.f;
#pragma unroll
    for (int i = 0; i < 4; ++i) den += expf(L[i] - gm);
    const float gwt = 1.0f / den;
    const LAS float* e = L + 4 + gs * 8;
    int i0 = 0; float v0 = e[0];
#pragma unroll
    for (int j = 1; j < 8; ++j) { const float v = e[j]; if (v > v0) { v0 = v; i0 = j; } }
    int i1 = (i0 == 0) ? 1 : 0; float v1 = e[i1];
#pragma unroll
    for (int j = 0; j < 8; ++j) { const float v = e[j]; if (j != i0 && v > v1) { v1 = v; i1 = j; } }
    const float t = expf(v1 - v0); const float p0 = 1.0f / (1.0f + t), p1 = t / (1.0f + t);
    if (writer) {
        const int e0 = gs * 8 + i0, e1 = gs * 8 + i1;
        eid[row * 2] = e0; eid[row * 2 + 1] = e1;
        gate[row * 2] = gwt * p0; gate[row * 2 + 1] = gwt * p1;
        const int a = (row & 127) * 2;
        le[a] = e0; le[a + 1] = e1;
        lr[a] = atomicAdd((int*)&hist[e0], 1); lr[a + 1] = atomicAdd((int*)&hist[e1], 1);
    }
}

__device__ __forceinline__ void norm2_router_mfma(const Ctx& X, int l) {
    const float* mod = (const float*)(X.ws + WS_MOD);
    const f16* Xb = (const f16*)(X.ws + WS_X); f16* H = (f16*)(X.ws + WS_H);
    const float* ssq = (const float*)(X.ws + WS_SSQ);
    int* eid = (int*)(X.ws + WS_EID); float* gate = (float*)(X.ws + WS_GATE); int* tokrank = (int*)(X.ws + WS_TOKPOS); int* list = (int*)(X.ws + WS_LIST);
    int* gcnt = (int*)(X.ws + WS_CTL) + CW_GCNT + l * 32;
    const f16* WR = (const f16*)(X.ws + WS_WR) + (size_t)l * 32 * 3 * 2 * 64 * 8;
    LAS float* Ac = (LAS float*)X.lds;
    LAS float* Sc = (LAS float*)(X.lds + 4096);
    LAS float* lbuf = (LAS float*)(X.lds + 8192 + X.wave * 3072);
    LAS int* hist = (LAS int*)(X.lds + 32768);
    LAS int* gbase = hist + 32;
    LAS int* le = hist + 64;
    LAS int* lr = hist + 320;
    const int r = X.lane & 15, q = X.lane >> 4;
    for (int ch = X.vcu; ch < T / 128; ch += X.G) {
        const int b = (ch * 128) >> 12;
        const float* ml = mod + (size_t)(l * 8 + b) * 6144;
        for (int c = X.tid; c < D; c += NTHREADS) { Ac[c] = X.in(I_NFG)[l * D + c] * (1.0f + ml[4096 + c]); Sc[c] = ml[3072 + c]; }
        if (X.tid < 32) hist[X.tid] = 0;
        __syncthreads();
        const int r0 = ch * 128 + X.wave * 16, row = r0 + r;
        float rstd;
        { const f32x4* sp = (const f32x4*)(ssq + (size_t)row * SSQ_SLOTS); const f32x4 s0 = sp[0], s1 = sp[1], s2 = sp[2], s3 = sp[3];
          const float tot = ((s0[0] + s0[1]) + (s0[2] + s0[3])) + ((s1[0] + s1[1]) + (s1[2] + s1[3])) + ((s2[0] + s2[1]) + (s2[2] + s2[3])) + ((s3[0] + s3[1]) + (s3[2] + s3[3]));
          rstd = 1.0f / sqrtf(tot * (1.f / D) + EPS); }
        f32x4 acc[3];
#pragma unroll
        for (int nb = 0; nb < 3; ++nb) acc[nb] = (f32x4){0.f, 0.f, 0.f, 0.f};
        const f16* xp = Xb + (size_t)row * D + 8 * q; f16* hp = H + (size_t)row * D + 8 * q;
        LAS unsigned char* WL = X.lds + 40960;
        f16x8 xa[8], xb[8];
#pragma unroll
        for (int k = 0; k < 8; ++k) { xa[k] = *(const f16x8*)(xp + 32 * k); xb[k] = *(const f16x8*)(xp + 32 * (8 + k)); }
#define ROUTER_STEP(S_, XH_) do { const int s = (S_); const f16x8 xh = (XH_); \
            f16x8 bh[3], bl[3]; _Pragma("unroll") for (int nb = 0; nb < 3; ++nb) { bh[nb] = *(const LAS f16x8*)(WL + ((((s & 15) * 3 + nb) * 2 + 0) * 64 + X.lane) * 16); bl[nb] = *(const LAS f16x8*)(WL + ((((s & 15) * 3 + nb) * 2 + 1) * 64 + X.lane) * 16); } \
            f32x4 x0, x1; _Pragma("unroll") for (int j = 0; j < 4; ++j) { x0[j] = (float)xh[j]; x1[j] = (float)xh[4 + j]; } \
            const f32x4 a0 = *(const LAS f32x4*)(Ac + 32 * s + 8 * q), a1 = *(const LAS f32x4*)(Ac + 32 * s + 8 * q + 4); \
            const f32x4 c0 = *(const LAS f32x4*)(Sc + 32 * s + 8 * q), c1 = *(const LAS f32x4*)(Sc + 32 * s + 8 * q + 4); \
            const f32x4 h0 = x0 * rstd * a0 + c0, h1 = x1 * rstd * a1 + c1; \
            f16x8 hi, lo; _Pragma("unroll") for (int j = 0; j < 4; ++j) { hi[j] = (f16)h0[j]; hi[4 + j] = (f16)h1[j]; lo[j] = (f16)(h0[j] - (float)hi[j]); lo[4 + j] = (f16)(h1[j] - (float)hi[4 + j]); } \
            *(f16x8*)(hp + 32 * s) = hi; \
            _Pragma("unroll") for (int nb = 0; nb < 3; ++nb) { \
                acc[nb] = __builtin_amdgcn_mfma_f32_16x16x32_f16(hi, bh[nb], acc[nb], 0, 0, 0); \
                acc[nb] = __builtin_amdgcn_mfma_f32_16x16x32_f16(lo, bh[nb], acc[nb], 0, 0, 0); \
                acc[nb] = __builtin_amdgcn_mfma_f32_16x16x32_f16(hi, bl[nb], acc[nb], 0, 0, 0); } } while (0)
#pragma unroll 1
        for (int hb = 0; hb < 2; ++hb) {
            __syncthreads();
            for (int i2 = X.tid; i2 < 16 * 3 * 2 * 64; i2 += NTHREADS) *(LAS u32x4*)(WL + (size_t)i2 * 16) = *(const u32x4*)(WR + ((size_t)hb * 16 * 3 * 2 * 64 + i2) * 8);
            __syncthreads();
#pragma unroll
            for (int k = 0; k < 8; ++k) ROUTER_STEP(16 * hb + k, xa[k]);
            if (hb == 0) {
#pragma unroll
                for (int k = 0; k < 8; ++k) xa[k] = *(const f16x8*)(xp + 32 * (16 + k));
            }
#pragma unroll
            for (int k = 0; k < 8; ++k) ROUTER_STEP(16 * hb + 8 + k, xb[k]);
            if (hb == 0) {
#pragma unroll
                for (int k = 0; k < 8; ++k) xb[k] = *(const f16x8*)(xp + 32 * (24 + k));
            }
        }
#undef ROUTER_STEP
#pragma unroll
        for (int nb = 0; nb < 3; ++nb) {
            const int col = 16 * nb + r; float bias = 0.f;
            if (col < 4) bias = X.in(I_BGR)[l * 4 + col]; else if (col < 36) bias = X.in(I_BER)[l * 32 + col - 4];
#pragma unroll
            for (int j = 0; j < 4; ++j) lbuf[(4 * q + j) * 48 + col] = acc[nb][j] * (1.0f / 1024.0f) + bias;
        }
        LDS_WAIT(); asm volatile("" ::: "memory");
        route_token(lbuf + r * 48, r0 + r, eid, gate, hist, le, lr, X.lane < 16);
        __syncthreads();
        if (X.tid < 32) gbase[X.tid] = atomicAdd(gcnt + X.tid, hist[X.tid]);
        __syncthreads();
        if (X.tid < 256) { const int e = le[X.tid], rank = gbase[e] + lr[X.tid]; const int token = ch * 128 + (X.tid >> 1);
            tokrank[token * 2 + (X.tid & 1)] = rank; list[(size_t)e * LCAP + rank] = token; }
        __syncthreads();
    }
}

__device__ __forceinline__ void conv_part(const Ctx& X, int i, int row0);
__device__ __forceinline__ int sgu_swz(int d) { return (d ^ (d >> 3)) & 15; }
__device__ __forceinline__ void mixer_mfma(const Ctx& X, int i) {
    const f16* Z = (const f16*)(X.ws + WS_Z); f16* YC = (f16*)(X.ws + WS_YCAT);
    const float* gv = X.in(I_SGUG) + (size_t)i * 512; const float* bsp = X.in(I_BSP) + (size_t)i * 8 * 128;
    const f16* WSP = (const f16*)(X.ws + WS_WSP) + (size_t)i * 8 * 128 * 128;
    const int hd = X.wave;
    LAS unsigned char* Tb = X.lds + hd * 16384;
    for (int ch = X.vcu; ch < T / 128; ch += X.G) {
        const int row0 = ch * 128;
        conv_part(X, i, row0);
        {
            const int d8 = X.lane & 7, tsub = X.lane >> 3;
            float g[8];
#pragma unroll
            for (int j = 0; j < 8; ++j) g[j] = gv[hd * 64 + 8 * d8 + j];
#pragma unroll 8
            for (int it = 0; it < 16; ++it) {
                const int t = 8 * it + tsub;
                const f16x8 v = *(const f16x8*)(Z + (size_t)(row0 + t) * INC + 512 + hd * 64 + 8 * d8);
                float f[8]; float ss = 0.f;
#pragma unroll
                for (int j = 0; j < 8; ++j) { f[j] = (float)v[j]; ss += f[j] * f[j]; }
                ss += dpp_f(ss, 0xB1); ss += dpp_f(ss, 0x4E); ss += dpp_f(ss, 0x141);
                const float rs = 1.0f / sqrtf(ss * (1.f / 64.f) + EPS);
#pragma unroll
                for (int j = 0; j < 8; ++j) { const int d = 8 * d8 + j;
                    *(LAS f16*)(Tb + d * 256 + ((it ^ sgu_swz(d)) << 4) + tsub * 2) = (f16)(f[j] * rs * g[j]); }
            }
        }
        LDS_WAIT(); asm volatile("" ::: "memory");
        {
            const int fr = X.lane & 15, q4 = X.lane >> 4;
            f16x8 Af[4][4];
#pragma unroll
            for (int db = 0; db < 4; ++db)
#pragma unroll
                for (int ks = 0; ks < 4; ++ks) { const int d = 16 * db + fr; Af[db][ks] = *(const LAS f16x8*)(Tb + d * 256 + (((4 * ks + q4) ^ sgu_swz(d)) << 4)); }
            f16x8 Bw[3][4]; f16x4 ur[3][4];
#pragma unroll
            for (int k = 0; k < 2; ++k) {
#pragma unroll
                for (int ks = 0; ks < 4; ++ks) if (ks <= (k >> 1)) Bw[k][ks] = *(const f16x8*)(WSP + (size_t)(hd * 128 + 16 * k + fr) * 128 + 8 * q4 + 32 * ks);
#pragma unroll
                for (int db = 0; db < 4; ++db) ur[k][db] = *(const f16x4*)(Z + (size_t)(row0 + 16 * k + fr) * INC + hd * 64 + 16 * db + 4 * q4);
            }
#pragma unroll
            for (int tb = 0; tb < 8; ++tb) {
                const int t = 16 * tb + fr;
                f16x8 Bf[4]; f16x4 uc[4];
#pragma unroll
                for (int ks = 0; ks < 4; ++ks) if (ks <= (tb >> 1)) Bf[ks] = Bw[tb % 3][ks];
#pragma unroll
                for (int db = 0; db < 4; ++db) uc[db] = ur[tb % 3][db];
                if (tb + 2 < 8) {
#pragma unroll
                    for (int ks = 0; ks < 4; ++ks) if (ks <= ((tb + 2) >> 1)) Bw[(tb + 2) % 3][ks] = *(const f16x8*)(WSP + (size_t)(hd * 128 + 16 * (tb + 2) + fr) * 128 + 8 * q4 + 32 * ks);
#pragma unroll
                    for (int db = 0; db < 4; ++db) ur[(tb + 2) % 3][db] = *(const f16x4*)(Z + (size_t)(row0 + 16 * (tb + 2) + fr) * INC + hd * 64 + 16 * db + 4 * q4);
                }
                f32x4 acc[4];
#pragma unroll
                for (int db = 0; db < 4; ++db) acc[db] = (f32x4){0.f, 0.f, 0.f, 0.f};
#pragma unroll
                for (int ks = 0; ks < 4; ++ks) {
                    if (ks <= (tb >> 1)) {
#pragma unroll
                        for (int db = 0; db < 4; ++db) acc[db] = __builtin_amdgcn_mfma_f32_16x16x32_f16(Af[db][ks], Bf[ks], acc[db], 0, 0, 0);
                    }
                }
                const float bias = bsp[hd * 128 + t];
#pragma unroll
                for (int db = 0; db < 4; ++db) {
                    const f16x4 u = uc[db];
                    u32x2 w; w.x = pkh((float)u[0] * (acc[db][0] + bias), (float)u[1] * (acc[db][1] + bias)); w.y = pkh((float)u[2] * (acc[db][2] + bias), (float)u[3] * (acc[db][3] + bias));
                    *(u32x2*)(YC + (size_t)(row0 + t) * D + hd * 64 + 16 * db + 4 * q4) = w;
                }
            }
        }
        LDS_WAIT(); asm volatile("" ::: "memory");
    }
}

__device__ __forceinline__ void conv_part(const Ctx& X, int i, int row0) {
    const f16* Z = (const f16*)(X.ws + WS_Z); f16* YC = (f16*)(X.ws + WS_YCAT);
    const float* cw = X.in(I_CONVW) + (size_t)i * 3 * 512;
    const int ch0 = 8 * X.lane;
    float w0[8], w1[8], w2[8];
#pragma unroll
    for (int j = 0; j < 8; ++j) { w0[j] = cw[ch0 + j]; w1[j] = cw[512 + ch0 + j]; w2[j] = cw[1024 + ch0 + j]; }
    const int t0 = row0 + 16 * X.wave;
    float zm2[8], zm1[8];
#pragma unroll
    for (int j = 0; j < 8; ++j) { zm2[j] = 0.f; zm1[j] = 0.f; }
    if ((t0 & (SEQ - 1)) >= 2) {
        const f16x8 c2 = *(const f16x8*)(Z + (size_t)(t0 - 2) * INC + 1536 + ch0), x2 = *(const f16x8*)(Z + (size_t)(t0 - 2) * INC + 2048 + ch0);
        const f16x8 c1 = *(const f16x8*)(Z + (size_t)(t0 - 1) * INC + 1536 + ch0), x1 = *(const f16x8*)(Z + (size_t)(t0 - 1) * INC + 2048 + ch0);
#pragma unroll
        for (int j = 0; j < 8; ++j) { zm2[j] = (float)c2[j] * (float)x2[j]; zm1[j] = (float)c1[j] * (float)x1[j]; }
    }
    f16x8 rb[4], rc[4], rx[4];
#pragma unroll
    for (int k = 0; k < 4; ++k) { const size_t row = (size_t)(t0 + k); rb[k] = *(const f16x8*)(Z + row * INC + 1024 + ch0); rc[k] = *(const f16x8*)(Z + row * INC + 1536 + ch0); rx[k] = *(const f16x8*)(Z + row * INC + 2048 + ch0); }
#pragma unroll
    for (int rr = 0; rr < 16; ++rr) {
        const size_t row = (size_t)(t0 + rr);
        const f16x8 bg = rb[rr & 3], cg = rc[rr & 3], xi = rx[rr & 3];
        if (rr + 4 < 16) { const size_t rn = row + 4; rb[rr & 3] = *(const f16x8*)(Z + rn * INC + 1024 + ch0); rc[rr & 3] = *(const f16x8*)(Z + rn * INC + 1536 + ch0); rx[rr & 3] = *(const f16x8*)(Z + rn * INC + 2048 + ch0); }
        float o[8];
#pragma unroll
        for (int j = 0; j < 8; ++j) { const float zt = (float)cg[j] * (float)xi[j]; o[j] = (float)bg[j] * (w0[j] * zm2[j] + w1[j] * zm1[j] + w2[j] * zt); zm2[j] = zm1[j]; zm1[j] = zt; }
        u32x4 w; w.x = pkh(o[0], o[1]); w.y = pkh(o[2], o[3]); w.z = pkh(o[4], o[5]); w.w = pkh(o[6], o[7]);
        *(u32x4*)(YC + row * D + 512 + ch0) = w;
    }
}
template <int J>
__device__ __forceinline__ void poolprep_group(const f16* H, f16* P, int r0, int lane, bool halo) {
    constexpr int WIN = 2 << J, NH = WIN - 1;
    const f16* hp = H + (size_t)r0 * D + 4 * lane + 256 * J;
    f16x4 v[NH + 16];
#pragma unroll
    for (int i = 0; i < NH + 16; ++i) {
        if (i < NH) { v[i] = (f16x4){(f16)0.f, (f16)0.f, (f16)0.f, (f16)0.f}; if (halo) v[i] = *(const f16x4*)(hp + (ptrdiff_t)(i - NH) * D); }
        else v[i] = *(const f16x4*)(hp + (size_t)(i - NH) * D);
    }
    f32x4 S = (f32x4){0.f, 0.f, 0.f, 0.f};
#pragma unroll
    for (int i = 0; i < NH; ++i) { S[0] += (float)v[i][0]; S[1] += (float)v[i][1]; S[2] += (float)v[i][2]; S[3] += (float)v[i][3]; }
    const int ts0 = r0 & (SEQ - 1);
#pragma unroll
    for (int rr = 0; rr < 16; ++rr) {
        const f16x4 h = v[NH + rr];
        S[0] += (float)h[0]; S[1] += (float)h[1]; S[2] += (float)h[2]; S[3] += (float)h[3];
        const int ts = ts0 + rr; const float ic = 1.0f / (float)((ts + 1 < WIN) ? ts + 1 : WIN);
        u32x2 w; w.x = pkh(S[0] * ic - (float)h[0], S[1] * ic - (float)h[1]); w.y = pkh(S[2] * ic - (float)h[2], S[3] * ic - (float)h[3]);
        *(u32x2*)(P + (size_t)(r0 + rr) * D + 4 * lane + 256 * J) = w;
        const f16x4 o = v[rr];
        S[0] -= (float)o[0]; S[1] -= (float)o[1]; S[2] -= (float)o[2]; S[3] -= (float)o[3];
    }
}
__device__ __forceinline__ void poolprep_phase(const Ctx& X) {
    const f16* H = (const f16*)(X.ws + WS_H); f16* P = (f16*)(X.ws + WS_YCAT);
    const int gw = X.vcu * NWAVES + X.wave, NGW = X.G * NWAVES;
    for (int r0 = gw * 16; r0 < T; r0 += NGW * 16) {
        const bool halo = (r0 & (SEQ - 1)) != 0;
        poolprep_group<0>(H, P, r0, X.lane, halo); poolprep_group<1>(H, P, r0, X.lane, halo);
        poolprep_group<2>(H, P, r0, X.lane, halo); poolprep_group<3>(H, P, r0, X.lane, halo);
    }
}

constexpr int N_PHASES = 2 + 8 * DEPTH;
__global__ void __launch_bounds__(NTHREADS, 2) fwd(Args a) {
    extern __shared__ __attribute__((aligned(16))) unsigned char lds_raw[];
    Ctx X;
    X.lds = (LAS unsigned char*)lds_raw;
    ctx_refresh(X);
    X.G = gridDim.x; { const int bx = blockIdx.x; X.bidx = bx; X.vcu = (X.G % 8 == 0) ? (bx % 8) * (X.G / 8) + bx / 8 : bx; }
    for (int u = X.tid; u < 64; u += NTHREADS) ((LAS unsigned*)(X.lds + LDS_MISC))[u] = 0u;
    __syncthreads();
#if N_LAUNCH_MODE == 1
    XcdBarrier bar = xcd_barrier_post((unsigned*)(X.ws + WS_CTL) + CW_BAR, (volatile LAS unsigned*)(X.lds + LDS_MISC));
#define GRID_BAR() xcd_barrier(bar)
    bool hwmode = false;
#define LOCAL_BAR() do { if (hwmode) xcd_local_barrier((unsigned*)(X.ws + WS_CTL), bar.bar, bar.x, (unsigned)(X.G / 8), bar.st); else xcd_barrier(bar); } while (0)
#else
#define GRID_BAR() do {} while (0)
#define LOCAL_BAR() do {} while (0)
#endif
    const int lo = a.ph_lo, hi = a.ph_hi;
#define IN(k) (lo <= (k) && (k) < hi && (ctx_refresh(X), true))
#define SEAM(k) do { if (IN(k) && IN((k) + 1)) GRID_BAR(); } while (0)
#define LSEAM(k) do { if (IN(k) && IN((k) + 1)) LOCAL_BAR(); } while (0)

    if (IN(0)) { for (int rep = 0; rep < NREP(0); ++rep) p0_prologue(X); SEAM(0); }
#if N_LAUNCH_MODE == 1 && XCD_LOCAL_SEAMS
    {
        hwmode = xcd_census_even(bar.bar);
        if (hwmode) { const int rank = (int)((volatile LAS unsigned*)(X.lds + LDS_MISC))[3]; X.vcu = (int)bar.x * (X.G / 8) + rank; X.bidx = rank * 8 + (int)bar.x; }
    }
#endif

    for (int l = 0; l < DEPTH; ++l) {
        const int pb = 1 + 8 * l, i = l >> 1;
        const float* mod = (const float*)(X.ws + WS_MOD);
        f16* Xb = (f16*)(X.ws + WS_X); f16* H = (f16*)(X.ws + WS_H); f16* YC = (f16*)(X.ws + WS_YCAT); f16* Z = (f16*)(X.ws + WS_Z);
        if (IN(pb + 0)) { if (l == 0) { for (int rep = 0; rep < NREP(8); ++rep) norm_phase<0>(X, l); } else norm_phase<1>(X, l); LSEAM(pb + 0); }
        if ((l & 1) == 0) {
            if (IN(pb + 1)) {
                DenseSched S; S.init(T, INC, X.G, X.bidx, false); EpiStoreF16 E{Z, INC};
                for (int rep = 0; rep < NREP(1); ++rep)
                run_gemm<DenseSched, EpiStoreF16, false, false>(X, H, D, (const f16*)(X.ws + WS_WIN) + (size_t)i * INC * D, D, nullptr, S, E);
                LSEAM(pb + 1);
            }
            if (IN(pb + 2)) { for (int rep = 0; rep < NREP(2); ++rep) mixer_mfma(X, i); LSEAM(pb + 2); }
            if (IN(pb + 3)) {
                DenseSched S; S.init(T, D, X.G, X.bidx, false);
                EpiResid E{Xb, mod + (size_t)l * 8 * 6144 + 2048, nullptr, (float*)(X.ws + WS_SSQ)};
                run_gemm<DenseSched, EpiResid, false, false>(X, YC, D, (const f16*)(X.ws + WS_WOUT) + (size_t)i * D * D, D, nullptr, S, E);
                LSEAM(pb + 3);
            }
        } else {
            if (IN(pb + 3)) {
                DenseSched S; S.init(T, D, X.G, X.bidx, true);
                { Unit u;
                  for (int i2 = 0; S.next(i2, u); ++i2) {
                      const bool halo0 = ((u.orow + 32 * X.wave) & (SEQ - 1)) != 0;
#pragma unroll
                      for (int k = 0; k < 2; ++k) { const int r0 = u.orow + 32 * X.wave + 16 * k; const bool halo = (k == 1) || halo0;
                          if (u.pn == 0) poolprep_group<0>(H, YC, r0, X.lane, halo); else if (u.pn == 1) poolprep_group<1>(H, YC, r0, X.lane, halo);
                          else if (u.pn == 2) poolprep_group<2>(H, YC, r0, X.lane, halo); else poolprep_group<3>(H, YC, r0, X.lane, halo); } }
                  asm volatile("s_waitcnt vmcnt(0)" ::: "memory"); __syncthreads();
                  if (X.tid == 0) { __builtin_amdgcn_fence(__ATOMIC_ACQUIRE, "agent"); asm volatile("s_waitcnt vmcnt(0)" ::: "memory"); }
                  __syncthreads(); }
                EpiResid E{Xb, mod + (size_t)l * 8 * 6144 + 2048, X.in(I_PSCALE) + (size_t)i * D, (float*)(X.ws + WS_SSQ)};
                run_gemm<DenseSched, EpiResid, false, false>(X, YC, D, (const f16*)(X.ws + WS_WPOOL) + (size_t)i * 4 * 256 * 256, 256, nullptr, S, E);
                LSEAM(pb + 3);
            }
        }
        if (IN(pb + 4)) { if (l > 0) moe_convert_batches(X, l, 1 << 30); norm2_router_mfma(X, l); SEAM(pb + 4); }
        if (IN(pb + 6)) {
            moe_tables(X, l);
            MoeSched S{(const LAS int*)(X.lds + LDS_TAB), X.G, X.vcu, 128, true}; EpiSiluMul E{(f16*)(X.ws + WS_ACT)};
            const int n_units = 4 * ((const LAS int*)(X.lds + LDS_TAB))[64];
            LAS int* ltok = (LAS int*)(X.lds + LDS_TAB + 2048);
            { MoeSched S0 = S; S0.lds_list = false; Unit u;
              for (int i2 = 0; i2 < 6 && S0.next(i2, u); ++i2) if (X.tid < 256) ltok[i2 * 256 + X.tid] = (X.tid < u.nvalid) ? ((const int*)(X.ws + WS_LIST))[u.lbase + X.tid] : 0;
              __syncthreads(); }
            run_gemm<MoeSched, EpiSiluMul, true, true>(X, H, D, (const f16*)(X.ws + WS_W1) + (size_t)l * 32 * 1024 * 1024, D, ltok, S, E);
            if (l + 1 < DEPTH) { const int mine = (n_units - X.vcu + X.G - 1) / X.G, most = (n_units + X.G - 1) / X.G; if (most > mine) moe_convert_batches(X, l + 1, (most - mine) * TAIL_Q1); }
            LSEAM(pb + 6);
        }
        if (IN(pb + 7)) {
            moe_tables(X, l);
            MoeSched S{(const LAS int*)(X.lds + LDS_TAB), X.G, X.vcu, 256, false}; EpiStoreF16 E{(f16*)(X.ws + WS_Y2), D};
            const int n_units = 4 * ((const LAS int*)(X.lds + LDS_TAB))[64];
            for (int rep = 0; rep < NREP(6); ++rep)
            run_gemm<MoeSched, EpiStoreF16, false, false>(X, (const f16*)(X.ws + WS_ACT), DE, (const f16*)(X.ws + WS_W2) + (size_t)l * 32 * 1024 * 512, DE, nullptr, S, E);
            if (l + 1 < DEPTH) { const int mine = (n_units - X.vcu + X.G - 1) / X.G, most = (n_units + X.G - 1) / X.G; if (most > mine) moe_convert_batches(X, l + 1, (most - mine) * TAIL_Q2); }
            SEAM(pb + 7);
        }
    }
    if (IN(1 + 8 * DEPTH)) norm_phase<2>(X, DEPTH);
#undef IN
#undef SEAM
#undef LSEAM
}

extern "C" void kernel_launch(void* const* d_in, const int* in_sizes, int n_in, void* d_out, int out_size, void* d_ws, size_t ws_size, hipStream_t stream) {
    static int grid = 0;
    if (grid == 0) {
        if (n_in != 22 || out_size != T * D || ws_size < WS_END) { fprintf(stderr, "kernel_launch: unexpected shapes (n_in %d out %d ws %zu, need %zu)\n", n_in, out_size, ws_size, (size_t)WS_END); grid = -1; return; }
        int dev = 0, cus = 0, per_cu = 0;
        if (hipGetDevice(&dev) != hipSuccess || hipDeviceGetAttribute(&cus, hipDeviceAttributeMultiprocessorCount, dev) != hipSuccess) { grid = -1; return; }
        if (hipFuncSetAttribute((const void*)fwd, hipFuncAttributeMaxDynamicSharedMemorySize, LDS_BYTES) != hipSuccess) { fprintf(stderr, "kernel_launch: hipFuncSetAttribute failed\n"); grid = -1; return; }
        if (hipOccupancyMaxActiveBlocksPerMultiprocessor(&per_cu, (const void*)fwd, NTHREADS, LDS_BYTES) != hipSuccess || per_cu < 1) { fprintf(stderr, "kernel_launch: occupancy query says %d\n", per_cu); }
        (void)hipGetLastError();
        grid = cus;
    }
    if (grid < 0) return;
    (void)hipMemsetAsync((char*)d_ws + WS_CTL, 0, CTL_ZERO_BYTES, stream);
    Args a{};
    for (int i = 0; i < 22; ++i) a.in[i] = (const float*)d_in[i];
    a.out = (float*)d_out; a.ws = (unsigned char*)d_ws;
#if N_LAUNCH_MODE == 1
    a.ph_lo = 0; a.ph_hi = N_PHASES;
    hipLaunchKernelGGL(fwd, dim3(grid), dim3(NTHREADS), LDS_BYTES, stream, a);
#else
    for (int p = 0; p < N_PHASES; ++p) {
        if (p >= 1 && p < 1 + 8 * DEPTH) { const int l = (p - 1) / 8, j = (p - 1) % 8; if (((l & 1) && (j == 1 || j == 2)) || j == 5) continue; }
        a.ph_lo = p; a.ph_hi = p + 1;
        hipLaunchKernelGGL(fwd, dim3(grid), dim3(NTHREADS), LDS_BYTES, stream, a);
    }
#endif
}
```

```cpp
#include <hip/hip_runtime.h>
#include <cstdio>
#include <cstdint>

#ifndef N_LAUNCH_MODE
#define N_LAUNCH_MODE 1
#endif

#ifndef DUP_MASK
#define DUP_MASK 0
#endif
#define NREP(k) (1 + ((DUP_MASK >> (k)) & 1))
#ifndef XCD_LOCAL_SEAMS
#define XCD_LOCAL_SEAMS 1
#endif
#ifndef NT_IN
#define NT_IN 1
#endif
#ifndef NT_Y2
#define NT_Y2 1
#endif
#ifndef NT_Z
#define NT_Z 1
#endif
#ifndef OUT_NT
#define OUT_NT 0
#endif
#define LDNT_IN(p) (NT_IN ? __builtin_nontemporal_load(p) : *(p))
#define LDNT_Y2(p) (NT_Y2 ? __builtin_nontemporal_load(p) : *(p))
#define LDNT_Z(p) (NT_Z ? __builtin_nontemporal_load(p) : *(p))
#ifndef CONV_ST_NT
#define CONV_ST_NT 1
#endif
#ifndef WGM_IN
#define WGM_IN 2
#endif
#ifndef Z_NT
#define Z_NT false
#endif
#ifndef ACT_NT
#define ACT_NT true
#endif
#ifndef X_NT
#define X_NT false
#endif
#ifndef Y2_NT
#define Y2_NT false
#endif
#ifndef TAIL_Q1
#define TAIL_Q1 6
#endif
#ifndef TAIL_Q2
#define TAIL_Q2 3
#endif
#define LAS __attribute__((address_space(3)))
typedef _Float16 f16;
typedef _Float16 f16x8 __attribute__((ext_vector_type(8)));
typedef _Float16 f16x4 __attribute__((ext_vector_type(4)));
typedef _Float16 f16x2 __attribute__((ext_vector_type(2)));
typedef float f32x4 __attribute__((ext_vector_type(4)));
typedef unsigned u32x4 __attribute__((ext_vector_type(4)));
typedef unsigned u32x2 __attribute__((ext_vector_type(2)));

constexpr int D = 1024, BATCH = 8, SEQ = 4096, T = BATCH * SEQ, DEPTH = 4;
constexpr int INC = 2560, CHUNK = 128, NE = 32, DE = 512;
constexpr int MAXROWS = 73728;
constexpr float EPS = 1e-6f;
constexpr int SSQ_SLOTS = 16;
constexpr int NWAVES = 8, NTHREADS = 512;

constexpr size_t MiB = 1u << 20;
constexpr size_t WS_CTL = 0, CTL_ZERO_BYTES = 65536;
constexpr size_t WS_MOD = 1 * MiB;
constexpr size_t WS_EID = 2 * MiB;
constexpr size_t WS_GATE = WS_EID + 256 * 1024;
constexpr size_t WS_TOKPOS = WS_GATE + 256 * 1024;
constexpr size_t WS_ROWTOK = WS_TOKPOS + 256 * 1024;
constexpr size_t WS_HIST = 4 * MiB;
constexpr size_t WS_TILE = WS_HIST + 64 * 1024;
constexpr size_t WS_SSQ = 6 * MiB;
constexpr size_t WS_WR = 8 * MiB;
constexpr size_t WS_WSP = 9 * MiB;
constexpr size_t WS_WPOOL = 10 * MiB;
constexpr size_t WS_WOUT = 12 * MiB;
constexpr size_t WS_WIN = 16 * MiB;
constexpr size_t WS_W1 = 32 * MiB;
constexpr size_t WS_W2 = 288 * MiB;
constexpr size_t WS_X = 416 * MiB;
constexpr size_t WS_H = 544 * MiB;
constexpr size_t WS_YCAT = 608 * MiB;
constexpr size_t WS_Y2 = 672 * MiB;
constexpr size_t WS_Z = 816 * MiB;
constexpr size_t WS_ACT = 816 * MiB;
constexpr size_t WS_LIST = 976 * MiB;
constexpr size_t WS_END = 984 * MiB;

constexpr int CW_BAR = 4096;
constexpr int CW_GCNT = 8192;
constexpr int LCAP = 65536;
constexpr int CW_QCNT = 2304;
constexpr int CW_FLAG = 15360;
constexpr int CW_LSUB = 13312, CW_LGEN = 14336;
constexpr int CW_TICKET = 12288;
constexpr int MOE_ITEMS = 32 * 384;

constexpr int LDS_RING = 131072;
constexpr int LDS_TAB = LDS_RING;
constexpr int LDS_MISC = 147456 - 256;
constexpr int LDS_BYTES = 147456;

#define LDS_WAIT() asm volatile("s_waitcnt lgkmcnt(0)" ::: "memory")
__device__ __forceinline__ unsigned pkh(float a, float b) { f16x2 v = {(f16)a, (f16)b}; return __builtin_bit_cast(unsigned, v); }
__device__ __forceinline__ int sidx(int v, int src) { return __builtin_amdgcn_ds_bpermute(src << 2, v); }
__device__ __forceinline__ float sidx(float v, int src) { return __builtin_bit_cast(float, __builtin_amdgcn_ds_bpermute(src << 2, __builtin_bit_cast(int, v))); }
__device__ __forceinline__ float sxor(float v, int m, int lane) { return sidx(v, lane ^ m); }
template <int CTRL> __device__ __forceinline__ float dpp_f_(float v) { return __builtin_bit_cast(float, __builtin_amdgcn_update_dpp(0, __builtin_bit_cast(int, v), CTRL, 0xF, 0xF, true)); }
#define dpp_f(v, ctrl) dpp_f_<ctrl>(v)
__device__ __forceinline__ float wave_sum(float v, int lane) {
#pragma unroll
    for (int o = 1; o < 64; o <<= 1) v += sxor(v, o, lane);
    return v;
}

#define XB_TMO      128
#define XB_XCNT(j)  (256  + 64 * (j))
#define XB_XSUB(j)  (1280 + 64 * (j))
#define XB_XGEN(j)  (2304 + 64 * (j))
#define XB_TOP      3328
#define XB_TOPGEN   3392
#define XCD_BAR_WORDS 3456
#define XB_SPIN_CAP (1u << 18)
__device__ __forceinline__ unsigned xb_ld(unsigned* p)              { return __hip_atomic_load(p, __ATOMIC_RELAXED, __HIP_MEMORY_SCOPE_AGENT); }
__device__ __forceinline__ unsigned xb_add(unsigned* p, unsigned v) { return __hip_atomic_fetch_add(p, v, __ATOMIC_RELAXED, __HIP_MEMORY_SCOPE_AGENT); }
__device__ __forceinline__ unsigned xb_xcc_id() { return (unsigned)__builtin_amdgcn_s_getreg((3 << 11) | 20) & 0xFu; }
#define XB_SPIN(cond, bar) do { unsigned _sp = 0; while (cond) { __builtin_amdgcn_s_sleep(1); \
    if ((++_sp & 255u) == 0u) { if (xb_ld(&(bar)[XB_TMO])) break; if (_sp > XB_SPIN_CAP) { atomicAdd(&(bar)[XB_TMO], 1u); break; } } } } while (0)
struct XcdBarrier { unsigned* bar; unsigned x; volatile LAS unsigned* st; };
__device__ __forceinline__ XcdBarrier xcd_barrier_post(unsigned* bar, volatile LAS unsigned* st) {
    XcdBarrier b; b.bar = bar; b.x = xb_xcc_id(); b.st = st;
    if (threadIdx.x == 0) st[3] = xb_add(&bar[XB_XCNT(b.x)], 1u);
    return b;
}
__device__ __forceinline__ void xcd_barrier_complete(unsigned* bar, unsigned x, unsigned& nloc, unsigned& nx) {
    const unsigned G = gridDim.x * gridDim.y * gridDim.z;
    unsigned sum, cnt, mine, sp = 0u;
    for (;;) {
        sum = 0u; cnt = 0u; mine = 0u;
        unsigned cj[16];
#pragma unroll
        for (unsigned j = 0; j < 16; ++j) cj[j] = xb_ld(&bar[XB_XCNT(j)]);
        __builtin_amdgcn_sched_barrier(0);
#pragma unroll
        for (unsigned j = 0; j < 16; ++j) { const unsigned c = cj[j]; sum += c; cnt += (c > 0u) ? 1u : 0u; mine = (j == x) ? c : mine; }
        if (sum == G) break;
        __builtin_amdgcn_s_sleep(1);
        if ((++sp & 255u) == 0u) { if (xb_ld(&bar[XB_TMO])) break; if (sp > XB_SPIN_CAP) { atomicAdd(&bar[XB_TMO], 1u); break; } }
    }
    nloc = mine > 0u ? mine : 1u; nx = cnt > 0u ? cnt : 1u;
}
__device__ __forceinline__ bool xcd_census_even(unsigned* bar) {
    const unsigned G = gridDim.x; bool ok = (G % 8u) == 0u;
    unsigned cj[16];
#pragma unroll
    for (unsigned j = 0; j < 16; ++j) cj[j] = xb_ld(&bar[XB_XCNT(j)]);
    __builtin_amdgcn_sched_barrier(0);
#pragma unroll
    for (unsigned j = 0; j < 16; ++j) { const unsigned c = cj[j]; ok = ok && (j < 8u ? c == G / 8u : c == 0u); }
    return ok;
}
__device__ __forceinline__ void xcd_local_barrier(unsigned* ctl, unsigned* bar, unsigned x, unsigned nloc, volatile LAS unsigned* st) {
    asm volatile("s_waitcnt vmcnt(0)" ::: "memory");
    __syncthreads();
    if (threadIdx.x == 0) {
        __builtin_amdgcn_s_waitcnt(0);
        const unsigned gen = st[4]; st[4] = gen + 1u;
        const unsigned old = xb_add(&ctl[CW_LSUB + 64 * x], 1u);
        if (old + 1u == (gen + 1u) * nloc) xb_add(&ctl[CW_LGEN + 64 * x], 1u);
        else XB_SPIN(xb_ld(&ctl[CW_LGEN + 64 * x]) == gen, bar);
        __builtin_amdgcn_fence(__ATOMIC_ACQUIRE, "agent");
        asm volatile("s_waitcnt vmcnt(0)" ::: "memory");
    }
    __syncthreads();
}
__device__ __forceinline__ void xcd_barrier(const XcdBarrier& b) {
    asm volatile("s_waitcnt vmcnt(0)" ::: "memory");
    __syncthreads();
    if (threadIdx.x == 0) {
        unsigned* bar = b.bar;
        __builtin_amdgcn_s_waitcnt(0);
        unsigned nloc = b.st[0], nx = b.st[1];
        if (nloc == 0u) { xcd_barrier_complete(bar, b.x, nloc, nx); b.st[0] = nloc; b.st[1] = nx; }
        const unsigned old = xb_add(&bar[XB_XSUB(b.x)], 1u);
        const unsigned gen = old / nloc;
        if (old + 1u == (gen + 1u) * nloc) {
            __builtin_amdgcn_fence(__ATOMIC_RELEASE, "agent");
            asm volatile("s_waitcnt vmcnt(0)" ::: "memory");
            const unsigned og = xb_add(&bar[XB_TOP], 1u);
            const unsigned tg = og / nx;
            if (og + 1u == (tg + 1u) * nx) xb_add(&bar[XB_TOPGEN], 1u);
            else XB_SPIN(xb_ld(&bar[XB_TOPGEN]) == tg, bar);
            __builtin_amdgcn_fence(__ATOMIC_ACQUIRE, "agent");
            xb_add(&bar[XB_XGEN(b.x)], 1u);
            asm volatile("s_waitcnt vmcnt(0)" ::: "memory");
        } else {
            XB_SPIN(xb_ld(&bar[XB_XGEN(b.x)]) == gen, bar);
            __builtin_amdgcn_fence(__ATOMIC_ACQUIRE, "agent");
            asm volatile("s_waitcnt vmcnt(0)" ::: "memory");
        }
    }
    __syncthreads();
}

struct Args { const float* in[22]; float* out; unsigned char* ws; int ph_lo, ph_hi; };
enum { I_X = 0, I_C, I_WADA, I_BADA, I_NMG, I_NFG, I_WIN, I_SGUG, I_WSP, I_BSP, I_CONVW, I_WOUT, I_WPOOL, I_PSCALE,
       I_WGR, I_BGR, I_WER, I_BER, I_MG, I_MU, I_MD, I_FNG };

typedef const __attribute__((address_space(4))) unsigned char* KP;
struct Ctx {
    LAS unsigned char* lds;
    int tid, lane, wave, G, vcu, bidx;
    KP kp;
    unsigned char* ws;
    __device__ __forceinline__ const float* in(int k) const { return *(const float* const __attribute__((address_space(4)))*)(kp + 8 * k); }
    __device__ __forceinline__ float* out() const { return *(float* const __attribute__((address_space(4)))*)(kp + 176); }
};
__device__ __forceinline__ void ctx_refresh(Ctx& X) {
    int t = threadIdx.x; asm volatile("" : "+v"(t)); X.tid = t; X.lane = t & 63; X.wave = __builtin_amdgcn_readfirstlane(t >> 6);
    KP k = (KP)__builtin_amdgcn_kernarg_segment_ptr(); asm volatile("" : "+s"(k)); X.kp = k;
    X.ws = *(unsigned char* const __attribute__((address_space(4)))*)(k + 184);
}
#ifndef WT_STORES
#define WT_STORES 0
#endif
__device__ __forceinline__ void st16(void* p, u32x4 v) {
#if WT_STORES
    asm volatile("global_store_dwordx4 %0, %1, off sc1\n\ts_nop 1" :: "v"(p), "v"(v) : "memory");
#else
    __builtin_nontemporal_store(v, (u32x4*)p);
#endif
}
struct Unit { int arow, acol, brow, orow, ocol, pn, lbase, nvalid; };

struct DenseSched {
    int nM, nN, nwg, G, c, wgm; bool acol_pn;
    __device__ void init(int M, int N, int G_, int c_, bool acol_pn_, int wgm_ = 8) { nM = M / 256; nN = N / 256; nwg = nM * nN; G = G_; c = c_; acol_pn = acol_pn_; wgm = wgm_; }
    __device__ __forceinline__ bool next(int i, Unit& u) const {
        const long L = (long)i * G + c; if (L >= nwg) return false;
        int wgid = (int)L; { const int q = nwg / 8, r = nwg % 8, xcd = wgid % 8, off = wgid / 8; wgid = (xcd < r ? xcd * (q + 1) : r * (q + 1) + (xcd - r) * q) + off; }
        const int nig = wgm * nN, gid = wgid / nig, fm = gid * wgm, gsz = (nM - fm) < wgm ? (nM - fm) : wgm;
        const int pm = fm + ((wgid % nig) % gsz), pn = (wgid % nig) / gsz;
        u.arow = pm * 256; u.acol = acol_pn ? pn * 256 : 0; u.brow = pn * 256; u.orow = pm * 256; u.ocol = pn * 256; u.pn = pn; u.lbase = 0; u.nvalid = 0; return true;
    }
};
struct MoeSched {
    const LAS int* tab; int G, vcu, ocol_step; bool lds_list;
    __device__ __forceinline__ bool next(int i, Unit& u) const {
        const int n_rt = __builtin_amdgcn_readfirstlane(tab[64]);
        const int L = i * G + vcu; if (L >= 4 * n_rt) return false;
        const int rt = L >> 2, pn = L & 3; const int e = __builtin_amdgcn_readfirstlane(tab[65 + rt]);
        const int loc = rt * 256 - __builtin_amdgcn_readfirstlane(tab[e]);
        u.arow = rt * 256; u.acol = 0; u.brow = e * 1024 + pn * 256; u.orow = rt * 256; u.ocol = pn * ocol_step; u.pn = pn;
        u.lbase = lds_list ? i * 256 : e * LCAP + loc; u.nvalid = __builtin_amdgcn_readfirstlane(tab[32 + e]) - loc; return true;
    }
};
__device__ __forceinline__ void moe_tables(const Ctx& X, int l) {
    LAS int* tab = (LAS int*)(X.lds + LDS_TAB);
    const int* gcnt = (const int*)(X.ws + WS_CTL) + CW_GCNT + l * 32;
    if (X.tid < 64) {
        const int e = X.lane & 31; const int c = gcnt[e]; const int p = (c + 255) & ~255;
        int incl = p;
#pragma unroll
        for (int o = 1; o < 32; o <<= 1) { const int t = sidx(incl, (X.lane & 32) + ((e - o) & 31)); if (e >= o) incl += t; }
        const int st = incl - p;
        if (X.lane < 32) { tab[e] = st; tab[32 + e] = c; if (e == 31) tab[64] = incl >> 8; for (int rt = st >> 8; rt < (incl >> 8); ++rt) tab[65 + rt] = e; }
    }
    __syncthreads();
}
template <bool NT = true>
struct EpiStoreF16 {
    static constexpr bool ROWSUM = false, PERM = true, PRELOAD = false;
    f16* O; int ldo;
    __device__ __forceinline__ float store8(const Unit& u, int r, int c, f32x4 v0, f32x4 v1) const {
        u32x4 w; w.x = pkh(v0[0], v0[1]); w.y = pkh(v0[2], v0[3]); w.z = pkh(v1[0], v1[1]); w.w = pkh(v1[2], v1[3]);
        if (NT) st16(O + (size_t)(u.orow + r) * ldo + u.ocol + c, w); else *(u32x4*)(O + (size_t)(u.orow + r) * ldo + u.ocol + c) = w;
        return 0.f;
    }
    __device__ __forceinline__ void dual8(const Unit&, int, int, f32x4, f32x4, f32x4, f32x4) const {}
    __device__ __forceinline__ float operator()(const Unit& u, int r, int c, f32x4 v) const {
        u32x2 w; w.x = pkh(v[0], v[1]); w.y = pkh(v[2], v[3]);
        *(u32x2*)(O + (size_t)(u.orow + r) * ldo + u.ocol + c) = w; return 0.f;
    }
    __device__ __forceinline__ void dual(const Unit&, int, int, f32x4, f32x4) const {}
    __device__ __forceinline__ void rowsum(const Unit&, int, int, float) const {}
};
template <bool HAS_PS>
struct EpiResid {
    static constexpr bool ROWSUM = true, PERM = true, PRELOAD = true;
    f16* Xh; const float* gm  ; const float* ps; float* ssq;
    typedef f16x8 Pre;
    struct Scale { f32x4 s0, s1, p0, p1; };
    __device__ __forceinline__ Scale scale8(const Unit& u, int c) const {
        const int col = u.ocol + c, b = u.orow >> 12; Scale S;
        S.s0 = *(const f32x4*)(gm + (size_t)b * 6144 + col); S.s1 = *(const f32x4*)(gm + (size_t)b * 6144 + col + 4);
        if (HAS_PS) { S.p0 = *(const f32x4*)(ps + col); S.p1 = *(const f32x4*)(ps + col + 4); }
        return S;
    }
    __device__ __forceinline__ Pre load8(const Unit& u, int r, int c) const { return *(const f16x8*)(Xh + (size_t)(u.orow + r) * D + u.ocol + c); }
    __device__ __forceinline__ float store8p(const Unit& u, int r, int c, f32x4 v0, f32x4 v1, const Pre& P, const Scale& S) const {
        const int row = u.orow + r, col = u.ocol + c;
        f32x4 x0, x1;
#pragma unroll
        for (int j = 0; j < 4; ++j) { x0[j] = (float)P[j]; x1[j] = (float)P[4 + j]; }
        if (HAS_PS) { x0 = x0 + (S.s0 * S.p0) * v0; x1 = x1 + (S.s1 * S.p1) * v1; } else { x0 = x0 + S.s0 * v0; x1 = x1 + S.s1 * v1; }
        u32x4 w; w.x = pkh(x0[0], x0[1]); w.y = pkh(x0[2], x0[3]); w.z = pkh(x1[0], x1[1]); w.w = pkh(x1[2], x1[3]);
        if (X_NT) st16(Xh + (size_t)row * D + col, w); else *(u32x4*)(Xh + (size_t)row * D + col) = w;
        return ((x0[0] * x0[0] + x0[1] * x0[1]) + (x0[2] * x0[2] + x0[3] * x0[3])) + ((x1[0] * x1[0] + x1[1] * x1[1]) + (x1[2] * x1[2] + x1[3] * x1[3]));
    }
    __device__ __forceinline__ float store8(const Unit&, int, int, f32x4, f32x4) const { return 0.f; }
    __device__ __forceinline__ void dual8(const Unit&, int, int, f32x4, f32x4, f32x4, f32x4) const {}
    __device__ __forceinline__ float operator()(const Unit&, int, int, f32x4) const { return 0.f; }
    __device__ __forceinline__ void dual(const Unit&, int, int, f32x4, f32x4) const {}
    __device__ __forceinline__ void rowsum(const Unit& u, int r, int wc, float s) const { ssq[(size_t)(u.orow + r) * SSQ_SLOTS + u.pn * 4 + wc] = s; }
};
struct EpiSiluMul {
    static constexpr bool ROWSUM = false, PERM = true, PRELOAD = false;
    f16* O;
    __device__ __forceinline__ float store8(const Unit&, int, int, f32x4, f32x4) const { return 0.f; }
    __device__ __forceinline__ void dual8(const Unit& u, int r, int c, f32x4 g0, f32x4 g1, f32x4 u0, f32x4 u1) const {
        float o[8];
#pragma unroll
        for (int j = 0; j < 4; ++j) { const float a0 = g0[j], a1 = g1[j];
            o[j] = a0 * __builtin_amdgcn_rcpf(1.f + __builtin_amdgcn_exp2f(-1.44269504f * a0)) * u0[j]; o[4 + j] = a1 * __builtin_amdgcn_rcpf(1.f + __builtin_amdgcn_exp2f(-1.44269504f * a1)) * u1[j]; }
        u32x4 w; w.x = pkh(o[0], o[1]); w.y = pkh(o[2], o[3]); w.z = pkh(o[4], o[5]); w.w = pkh(o[6], o[7]);
        if (ACT_NT) st16(O + (size_t)(u.orow + r) * DE + u.ocol + c, w); else *(u32x4*)(O + (size_t)(u.orow + r) * DE + u.ocol + c) = w;
    }
    __device__ __forceinline__ float operator()(const Unit&, int, int, f32x4) const { return 0.f; }
    __device__ __forceinline__ void dual(const Unit& u, int r, int c, f32x4 g, f32x4 up) const {
        float o[4];
#pragma unroll
        for (int j = 0; j < 4; ++j) { const float a = g[j]; o[j] = a / (1.f + __expf(-a)) * up[j]; }
        u32x2 w; w.x = pkh(o[0], o[1]); w.y = pkh(o[2], o[3]);
        *(u32x2*)(O + (size_t)(u.orow + r) * DE + u.ocol + c) = w;
    }
    __device__ __forceinline__ void rowsum(const Unit&, int, int, float) const {}
};

__device__ __forceinline__ int lds_byte(int r, int c) { const int st = (r >> 4) * 2 + (c >> 5), rr = r & 15, cc = c & 31, ob = rr * 64 + cc * 2; return st * 1024 + (ob ^ (((ob >> 9) & 1) << 5)); }
__device__ __forceinline__ void stage_rc(int b, int& R, int& C) { const int st = b / 1024, sb = b % 1024, swz = sb ^ (((sb >> 9) & 1) << 5); R = (st >> 1) * 16 + swz / 64; C = (st & 1) * 32 + (swz % 64) / 2; }
constexpr int HTB = 128 * 64 * 2;
template <class Epi, class Sched, bool GATHER, bool DUAL>
__device__ __forceinline__ void gemm8(LAS unsigned char* lds, const f16* A, const int lda, const f16* Bt, const int K, const LAS int* ltok, const Sched& S, const Epi& E) {
    int tz = threadIdx.x; asm volatile("" : "+v"(tz));
    const int tid = tz, wid = __builtin_amdgcn_readfirstlane(tid >> 6), lane = tid & 63, wr = wid >> 2, wc = wid & 3, fr = lane & 15, fq = lane >> 4;
    const int nt = K / 64;
    unsigned voffB[2];
#pragma unroll
    for (int i = 0; i < 2; ++i) { int R_, C_; stage_rc(tid * 16 + i * 8192, R_, C_); int Rb = R_;
        if (Epi::PERM) { const int rho = R_ & 31, pn_ = rho >> 4, pi_ = rho & 15; Rb = (R_ & ~31) + 8 * (pi_ >> 2) + 4 * pn_ + (pi_ & 3); }
        voffB[i] = (unsigned)(Rb * K + C_) * 2u; }
    const size_t kstep = 128;
    const size_t hstepB = (size_t)128 * K * 2;
    const unsigned ldsw = (unsigned)wid * 1024u;
    const int aoff = lds_byte(wr * 64 + fr, fq * 8), boff = lds_byte(wc * 32 + fr, fq * 8);
#define G8_SA(b, h) (((b) * 2 + (h)) * HTB)
#define G8_SB(b, h) ((4 + (b) * 2 + (h)) * HTB)
#define G8_STAGE(bufoff, gbase, voff) do { _Pragma("unroll") for (int _i = 0; _i < 2; ++_i) \
        __builtin_amdgcn_global_load_lds((const unsigned*)((const char*)(gbase) + (voff)[_i]), (LAS unsigned*)(lds + (bufoff) + ldsw + _i * 8192), 16, 0, 0); } while (0)
#define G8_LDA(dst, b, h) do { _Pragma("unroll") for (int m = 0; m < 4; ++m) _Pragma("unroll") for (int k = 0; k < 2; ++k) dst[m][k] = *(const LAS f16x8*)(lds + G8_SA(b, h) + aoff + m * 2048 + k * 1024); } while (0)
#define G8_LDB(dst, b, h) do { _Pragma("unroll") for (int n = 0; n < 2; ++n) _Pragma("unroll") for (int k = 0; k < 2; ++k) dst[n][k] = *(const LAS f16x8*)(lds + G8_SB(b, h) + boff + n * 2048 + k * 1024); } while (0)
#define G8_MMA(ai, bj, At, Bt_) do { __builtin_amdgcn_s_setprio(1); _Pragma("unroll") for (int m = 0; m < 4; ++m) _Pragma("unroll") for (int n = 0; n < 2; ++n) _Pragma("unroll") for (int k = 0; k < 2; ++k) \
        acc[ai][bj][m][n] = __builtin_amdgcn_mfma_f32_16x16x32_f16(Bt_[n][k], At[m][k], acc[ai][bj][m][n], 0, 0, 0); __builtin_amdgcn_s_setprio(0); } while (0)
#define G8_WAIT_V(n) asm volatile("s_waitcnt vmcnt(" #n ")" ::: "memory")
#define G8_WAIT_L(n) asm volatile("s_waitcnt lgkmcnt(" #n ")" ::: "memory")
#define G8_BAR __builtin_amdgcn_s_barrier()
#define G8_SCHED __builtin_amdgcn_sched_barrier(0)
#define G8_VOFFA(vo, u) do { _Pragma("unroll") for (int _h = 0; _h < 2; ++_h) _Pragma("unroll") for (int _i = 0; _i < 2; ++_i) { int _R, _C; stage_rc(tid * 16 + _i * 8192, _R, _C); const int _idx = _h * 128 + _R; \
        const int _g = GATHER ? ltok[(u).lbase + _idx] : (u).arow + _idx; (vo)[_h][_i] = (unsigned)(_g * lda + _C) * 2u; } \
        asm volatile("" : "+v"((vo)[0][0]), "+v"((vo)[0][1]), "+v"((vo)[1][0]), "+v"((vo)[1][1])); } while (0)
    Unit cur, nxt; int ui = 0;
    if (!S.next(0, cur)) return;
    f32x4 acc[2][2][4][2];
#pragma unroll
    for (int a = 0; a < 2; ++a)
#pragma unroll
        for (int b = 0; b < 2; ++b)
#pragma unroll
            for (int m = 0; m < 4; ++m)
#pragma unroll
                for (int n = 0; n < 2; ++n) acc[a][b][m][n] = (f32x4){0.f, 0.f, 0.f, 0.f};
    f16x8 At[4][2], B0[2][2], B1[2][2];
    unsigned voffA[2][2], nvoffA[2][2];
    G8_VOFFA(voffA, cur);
    const char* cA = (const char*)A + (size_t)cur.acol * 2; const char* cB = (const char*)Bt + (size_t)cur.brow * K * 2;
    G8_STAGE(G8_SB(0, 0), cB, voffB); G8_STAGE(G8_SB(0, 1), cB + hstepB, voffB); G8_STAGE(G8_SA(0, 0), cA, voffA[0]); G8_STAGE(G8_SA(0, 1), cA, voffA[1]);
    if (wr == 1) G8_BAR;
    G8_WAIT_V(2); G8_BAR;
    G8_STAGE(G8_SB(1, 0), cB + kstep, voffB); G8_STAGE(G8_SA(1, 0), cA + kstep, voffA[0]); G8_STAGE(G8_SB(1, 1), cB + hstepB + kstep, voffB);
    G8_WAIT_V(6); G8_BAR;
    for (;;) {
        const bool has_next = S.next(ui + 1, nxt);
        const char* nA = cA; const char* nB = cB;
        if (has_next) { G8_VOFFA(nvoffA, nxt); nA = (const char*)A + (size_t)nxt.acol * 2; nB = (const char*)Bt + (size_t)nxt.brow * K * 2; }
        else {
#pragma unroll
            for (int h = 0; h < 2; ++h)
#pragma unroll
                for (int i = 0; i < 2; ++i) nvoffA[h][i] = voffA[h][i];
        }
        for (int t = 0; t < nt; t += 2) {
            const bool last = (t == nt - 2);
            const char* a1 = cA + (size_t)(t + 1) * kstep;
            const char* a2 = last ? nA : cA + (size_t)(t + 2) * kstep; const char* b2 = last ? nB : cB + (size_t)(t + 2) * kstep;
            const char* a3 = a2 + kstep; const char* b3 = b2 + kstep;
            unsigned v2[2][2];
#pragma unroll
            for (int h = 0; h < 2; ++h)
#pragma unroll
                for (int i = 0; i < 2; ++i) v2[h][i] = last ? nvoffA[h][i] : voffA[h][i];
            G8_LDB(B0, 0, 0); G8_LDB(B1, 0, 1); G8_SCHED; G8_LDA(At, 0, 0); G8_STAGE(G8_SA(1, 1), a1, voffA[1]);
            G8_WAIT_V(8); G8_WAIT_L(0); G8_BAR; G8_MMA(0, 0, At, B0); G8_MMA(0, 1, At, B1); G8_BAR; G8_SCHED;
            G8_LDA(At, 0, 1); G8_STAGE(G8_SB(0, 0), b2, voffB); G8_STAGE(G8_SB(0, 1), b2 + hstepB, voffB); G8_STAGE(G8_SA(0, 0), a2, v2[0]);
            G8_WAIT_V(8); G8_WAIT_L(0); G8_BAR; G8_MMA(1, 0, At, B0); G8_MMA(1, 1, At, B1); G8_BAR; G8_SCHED;
            G8_LDB(B0, 1, 0); G8_LDB(B1, 1, 1); G8_SCHED; G8_LDA(At, 1, 0); G8_STAGE(G8_SA(0, 1), a2, v2[1]);
            G8_WAIT_V(8); G8_WAIT_L(0); G8_BAR; G8_MMA(0, 0, At, B0); G8_MMA(0, 1, At, B1); G8_BAR; G8_SCHED;
            G8_LDA(At, 1, 1); G8_STAGE(G8_SB(1, 0), b3, voffB); G8_STAGE(G8_SB(1, 1), b3 + hstepB, voffB); G8_STAGE(G8_SA(1, 0), a3, v2[0]);
            G8_WAIT_V(8); G8_WAIT_L(0); G8_BAR; G8_MMA(1, 0, At, B0); G8_MMA(1, 1, At, B1); G8_BAR; G8_SCHED;
        }
        if (wr == 0) G8_BAR;
        if constexpr (Epi::PRELOAD) {
            typename Epi::Scale SC[2];
#pragma unroll
            for (int bj = 0; bj < 2; ++bj) SC[bj] = E.scale8(cur, bj * 128 + wc * 32 + fq * 8);
#pragma unroll
            for (int ai = 0; ai < 2; ++ai) {
                typename Epi::Pre PR[4][2];
#pragma unroll
                for (int m = 0; m < 4; ++m)
#pragma unroll
                    for (int bj = 0; bj < 2; ++bj) PR[m][bj] = E.load8(cur, ai * 128 + wr * 64 + m * 16 + fr, bj * 128 + wc * 32 + fq * 8);
#pragma unroll
                for (int m = 0; m < 4; ++m) {
                    const int r = ai * 128 + wr * 64 + m * 16 + fr; float ss = 0.f;
#pragma unroll
                    for (int bj = 0; bj < 2; ++bj) ss += E.store8p(cur, r, bj * 128 + wc * 32 + fq * 8, acc[ai][bj][m][0], acc[ai][bj][m][1], PR[m][bj], SC[bj]);
                    ss += sxor(ss, 16, lane); ss += sxor(ss, 32, lane); if (fq == 0) E.rowsum(cur, r, wc, ss);
                }
            }
        } else {
#pragma unroll
        for (int ai = 0; ai < 2; ++ai)
#pragma unroll
            for (int m = 0; m < 4; ++m) {
                const int r = ai * 128 + wr * 64 + m * 16 + fr; float ss = 0.f;
                if (Epi::PERM) {
                    if (!DUAL) {
#pragma unroll
                        for (int bj = 0; bj < 2; ++bj) ss += E.store8(cur, r, bj * 128 + wc * 32 + fq * 8, acc[ai][bj][m][0], acc[ai][bj][m][1]);
                    } else E.dual8(cur, r, wc * 32 + fq * 8, acc[ai][0][m][0], acc[ai][0][m][1], acc[ai][1][m][0], acc[ai][1][m][1]);
                } else if (!DUAL) {
#pragma unroll
                    for (int bj = 0; bj < 2; ++bj)
#pragma unroll
                        for (int n = 0; n < 2; ++n) ss += E(cur, r, bj * 128 + wc * 32 + n * 16 + fq * 4, acc[ai][bj][m][n]);
                } else {
#pragma unroll
                    for (int n = 0; n < 2; ++n) E.dual(cur, r, wc * 32 + n * 16 + fq * 4, acc[ai][0][m][n], acc[ai][1][m][n]);
                }
                if (Epi::ROWSUM) { ss += sxor(ss, 16, lane); ss += sxor(ss, 32, lane); if (fq == 0) E.rowsum(cur, r, wc, ss); }
            }
        }
        if (!has_next) break;
#pragma unroll
        for (int a = 0; a < 2; ++a)
#pragma unroll
            for (int b = 0; b < 2; ++b)
#pragma unroll
                for (int m = 0; m < 4; ++m)
#pragma unroll
                    for (int n = 0; n < 2; ++n) acc[a][b][m][n] = (f32x4){0.f, 0.f, 0.f, 0.f};
        cur = nxt; cA = nA; cB = nB; ++ui;
#pragma unroll
        for (int h = 0; h < 2; ++h)
#pragma unroll
            for (int i = 0; i < 2; ++i) voffA[h][i] = nvoffA[h][i];
        if (wr == 1) G8_BAR;
    }
    G8_WAIT_V(0);
    G8_BAR;
#undef G8_SA
#undef G8_SB
#undef G8_STAGE
#undef G8_LDA
#undef G8_LDB
#undef G8_MMA
#undef G8_WAIT_V
#undef G8_WAIT_L
#undef G8_BAR
#undef G8_SCHED
#undef G8_VOFFA
}

template <class Sched, class Epi, bool GATHER, bool DUAL>
__device__ __forceinline__ void run_gemm(const Ctx& X, const f16* A, int lda, const f16* Bt, int K, const LAS int* ltok, const Sched& S, const Epi& E) {
    gemm8<Epi, Sched, GATHER, DUAL>(X.lds, A, lda, Bt, K, ltok, S, E);
}

constexpr int TR_TILE_BYTES = 64 * 65 * 4;
__device__ __forceinline__ void tr_item(const float* W, int K, int N, f16* WT, int ldd, int mapmode, LAS float* scr, int item, int lane) {
    const int nblk = N / 64, kb = item / nblk, nb = item % nblk, k0 = 64 * kb, n0 = 64 * nb;
    const int c16 = lane & 15, kr = lane >> 4;
    f32x4 v[16];
#pragma unroll
    for (int i = 0; i < 16; ++i) v[i] = __builtin_nontemporal_load((const f32x4*)(W + (size_t)(k0 + 4 * i + kr) * N + n0 + 4 * c16));
#pragma unroll
    for (int i = 0; i < 16; ++i) { LAS float* d = scr + (4 * i + kr) * 65 + 4 * c16; d[0] = v[i][0]; d[1] = v[i][1]; d[2] = v[i][2]; d[3] = v[i][3]; }
    LDS_WAIT(); asm volatile("" ::: "memory");
    const int c = lane & 7;
#pragma unroll
    for (int j = 0; j < 8; ++j) {
        const int nl = (lane >> 3) + 8 * j, n = n0 + nl; const LAS float* s = scr + (8 * c) * 65 + nl;
        u32x4 o; o.x = pkh(s[0 * 65], s[1 * 65]); o.y = pkh(s[2 * 65], s[3 * 65]); o.z = pkh(s[4 * 65], s[5 * 65]); o.w = pkh(s[6 * 65], s[7 * 65]);
        int drow = n;
        if (mapmode == 1) drow = 256 * (n >> 7) + (n & 127);
        else if (mapmode == 2) drow = 256 * (n >> 7) + (n & 127) + 128;
        if (CONV_ST_NT) __builtin_nontemporal_store(o, (u32x4*)(WT + (size_t)drow * ldd + k0 + 8 * c)); else *(u32x4*)(WT + (size_t)drow * ldd + k0 + 8 * c) = o;
    }
    LDS_WAIT(); asm volatile("" ::: "memory");
}

__device__ __forceinline__ void mod_item(const Ctx& X, int item) {
    LAS float* cact = (LAS float*)X.lds;
    LAS float* red = (LAS float*)(X.lds + 32768);
    const float* c = X.in(I_C); const float* w_ada = X.in(I_WADA); const float* b_ada = X.in(I_BADA);
    float* mod = (float*)(X.ws + WS_MOD);
    const int l = item / 48, jc = item % 48;
    for (int i = X.tid; i < 8192; i += NTHREADS) { const int b = i >> 10, k = i & 1023; const float v = c[b * 1024 + k]; cact[k * 8 + b] = v / (1.f + expf(-v)); }
    __syncthreads();
    const int c4 = X.lane & 31, ks = X.lane >> 5;
    const float* wp = w_ada + (size_t)l * 1024 * 6144 + jc * 128 + c4 * 4;
    f32x4 acc[8];
#pragma unroll
    for (int b = 0; b < 8; ++b) acc[b] = (f32x4){0.f, 0.f, 0.f, 0.f};
    const float* pw = wp + (size_t)(X.wave * 128 + ks) * 6144;
#pragma unroll 1
    for (int kb = 0; kb < 64; kb += 16) {
        f32x4 wr[16];
#pragma unroll
        for (int u = 0; u < 16; ++u) wr[u] = LDNT_IN((const f32x4*)(pw + (size_t)(kb + u) * 12288));
        __builtin_amdgcn_sched_barrier(0);
#pragma unroll
        for (int u = 0; u < 16; ++u) {
            const int k = X.wave * 128 + 2 * (kb + u) + ks; const f32x4 w = wr[u];
            const f32x4 c0 = *(const LAS f32x4*)(cact + k * 8), c1 = *(const LAS f32x4*)(cact + k * 8 + 4);
            acc[0] += c0[0] * w; acc[1] += c0[1] * w; acc[2] += c0[2] * w; acc[3] += c0[3] * w;
            acc[4] += c1[0] * w; acc[5] += c1[1] * w; acc[6] += c1[2] * w; acc[7] += c1[3] * w;
        }
        __builtin_amdgcn_sched_barrier(0);
    }
#pragma unroll
    for (int b = 0; b < 8; ++b)
#pragma unroll
        for (int j = 0; j < 4; ++j) acc[b][j] += sxor(acc[b][j], 32, X.lane);
    if (X.lane < 32) {
#pragma unroll
        for (int b = 0; b < 8; ++b) *(LAS f32x4*)(red + (X.wave * 8 + b) * 128 + c4 * 4) = acc[b];
    }
    __syncthreads();
    for (int o = X.tid; o < 1024; o += NTHREADS) {
        const int b = o >> 7, col = o & 127; float s = b_ada[l * 6144 + jc * 128 + col];
#pragma unroll
        for (int w = 0; w < 8; ++w) s += red[(w * 8 + b) * 128 + col];
        if ((l & 1) && jc >= 16 && jc < 24) s *= X.in(I_PSCALE)[(l >> 1) * D + (jc - 16) * 128 + col];
        mod[(size_t)(l * 8 + b) * 6144 + jc * 128 + col] = s;
    }
    __syncthreads();
}

__device__ __forceinline__ void moe_item(const Ctx& X, int L, int it, LAS float* scr) {
    f16* W1 = (f16*)(X.ws + WS_W1); f16* W2 = (f16*)(X.ws + WS_W2);
    const int le = L * 32 + it / 384, q = it % 384, which = q >> 7, item = q & 127;
    if (which == 0) tr_item(X.in(I_MG) + (size_t)le * D * DE, D, DE, W1 + (size_t)le * 1024 * 1024, D, 1, scr, item, X.lane);
    else if (which == 1) tr_item(X.in(I_MU) + (size_t)le * D * DE, D, DE, W1 + (size_t)le * 1024 * 1024, D, 2, scr, item, X.lane);
    else tr_item(X.in(I_MD) + (size_t)le * DE * D, DE, D, W2 + (size_t)le * 1024 * 512, DE, 0, scr, item, X.lane);
}
__device__ __forceinline__ void moe_convert_batches(const Ctx& X, int L, int max_batches) {
    LAS int* slot = (LAS int*)(X.lds + LDS_MISC + 64);
    unsigned* ticket = (unsigned*)(X.ws + WS_CTL) + CW_TICKET + L * 64;
    LAS float* scr = (LAS float*)(X.lds + X.wave * TR_TILE_BYTES);
    for (int b = 0; b < max_batches; ++b) {
        __syncthreads();
        if (X.tid == 0) *slot = (int)atomicAdd(ticket, 8u);
        __syncthreads();
        const int base = *slot;
        if (base >= MOE_ITEMS) break;
        moe_item(X, L, base + X.wave, scr);
    }
    __syncthreads();
}
__device__ __forceinline__ void p0_prologue(const Ctx& X) {
    __syncthreads();
    int it0 = X.vcu; if (X.G == 256) { const int xc = X.vcu >> 5, ix = X.vcu & 31; it0 = ix < 24 ? xc * 24 + ix : 192; }
    for (int it = it0; it < 192; it += X.G) mod_item(X, it);
    LAS float* scr = (LAS float*)(X.lds + X.wave * TR_TILE_BYTES);
    const int gw = X.vcu * NWAVES + X.wave, NGW = X.G * NWAVES;
    f16* WIN = (f16*)(X.ws + WS_WIN); f16* WOUT = (f16*)(X.ws + WS_WOUT); f16* WPOOL = (f16*)(X.ws + WS_WPOOL);
    constexpr int N_IN = 2 * 640, N_OUT = 2 * 256, N_POOL = 8 * 16;
    for (int it = gw; it < N_IN + N_OUT + N_POOL; it += NGW) {
        int r = it;
        if (r < N_IN) { const int i = r / 640, q = r % 640; tr_item(X.in(I_WIN) + (size_t)i * D * INC, D, INC, WIN + (size_t)i * INC * D, D, 0, scr, q, X.lane); continue; } r -= N_IN;
        if (r < N_OUT) { const int i = r / 256, q = r % 256; tr_item(X.in(I_WOUT) + (size_t)i * D * D, D, D, WOUT + (size_t)i * D * D, D, 0, scr, q, X.lane); continue; } r -= N_OUT;
        { const int ig = r / 16, q = r % 16; tr_item(X.in(I_WPOOL) + (size_t)ig * 256 * 256, 256, 256, WPOOL + (size_t)ig * 256 * 256, 256, 0, scr, q, X.lane); }
    }
    {
        f16* WR = (f16*)(X.ws + WS_WR);
        const size_t gt = (size_t)X.vcu * NTHREADS + X.tid, NGT = (size_t)X.G * NTHREADS;
        for (size_t idx = gt; idx < (size_t)4 * 32 * 3 * 2 * 64 * 8; idx += NGT) {
            const int jj = (int)(idx & 7), ln = (int)((idx >> 3) & 63), hl = (int)((idx >> 9) & 1); const int r3 = (int)(idx >> 10);
            const int nb = r3 % 3, s = (r3 / 3) & 31, l = r3 / 96;
            const int col = 16 * nb + (ln & 15), k = 32 * s + 8 * (ln >> 4) + jj;
            float w = 0.f;
            if (col < 4) w = X.in(I_WGR)[((size_t)l * D + k) * 4 + col]; else if (col < 36) w = X.in(I_WER)[((size_t)l * D + k) * 32 + col - 4];
            w *= 1024.f; const f16 hi = (f16)w; const f16 lo = (f16)(w - (float)hi);
            WR[idx] = hl ? lo : hi;
        }
    }
    {
        f16* WSP = (f16*)(X.ws + WS_WSP); const float* wsp = X.in(I_WSP);
        const size_t gt = (size_t)X.vcu * NTHREADS + X.tid, NGT = (size_t)X.G * NTHREADS;
        for (size_t i = gt; i < (size_t)2 * 8 * 128 * 128; i += NGT) { const int s = (int)(i & 127), t = (int)((i >> 7) & 127); WSP[i] = (f16)(s <= t ? wsp[i] : 0.f); }
    }
    moe_convert_batches(X, 0, 1 << 30);
}

struct NormRow { f32x4 x[4]; f16x4 xh[4], y0[4], y1[4]; };
template <int MODE>
__device__ __forceinline__ void norm_load(NormRow& R, const float* xsrc, const f16* Xh, const f16* Y2, int row, int lane, int p0, int p1) {
    if (MODE == 0) {
#pragma unroll
        for (int j = 0; j < 4; ++j) R.x[j] = LDNT_IN((const f32x4*)(xsrc + (size_t)row * D + 4 * lane + 256 * j));
    } else {
#pragma unroll
        for (int j = 0; j < 4; ++j) R.xh[j] = *(const f16x4*)(Xh + (size_t)row * D + 4 * lane + 256 * j);
    }
    if (MODE != 0) {
#pragma unroll
        for (int j = 0; j < 4; ++j) { R.y0[j] = LDNT_Y2((const f16x4*)(Y2 + (size_t)p0 * D + 4 * lane + 256 * j)); R.y1[j] = LDNT_Y2((const f16x4*)(Y2 + (size_t)p1 * D + 4 * lane + 256 * j)); }
    }
}
template <int MODE>
__device__ __forceinline__ void norm_phase(const Ctx& X, int l) {
    const float* mod = (const float*)(X.ws + WS_MOD);
    f16* Xb = (f16*)(X.ws + WS_X); f16* H = (f16*)(X.ws + WS_H);
    const f16* Y2 = (const f16*)(X.ws + WS_Y2);
    const int* tokpos = (const int*)(X.ws + WS_TOKPOS); const float* gate = (const float*)(X.ws + WS_GATE); const int* eid = (const int*)(X.ws + WS_EID);
    const int* gcnt = (const int*)(X.ws + WS_CTL) + CW_GCNT + (l - 1) * 32;
    const float* xsrc = X.in(I_X);
    const int gw = X.vcu * NWAVES + X.wave, NGW = X.G * NWAVES;
    for (int r0 = gw * 16; r0 < T; r0 += NGW * 16) {
        const int b = r0 >> 12;
        int tp = 0; float gt = 0.f; int cnt_e = 0, ee = 0, rk = 0;
        if (MODE != 0) { const int a2 = r0 * 2 + (X.lane & 31); cnt_e = gcnt[X.lane & 31]; ee = eid[a2]; rk = tokpos[a2]; gt = gate[a2]; }
        f32x4 A[4], S[4], GF[4], Bm[4];
#pragma unroll
        for (int j = 0; j < 4; ++j) {
            const int c = 4 * X.lane + 256 * j;
            if (MODE == 2) { A[j] = *(const f32x4*)(X.in(I_FNG) + c); S[j] = (f32x4){0.f, 0.f, 0.f, 0.f}; Bm[j] = (f32x4){0.f, 0.f, 0.f, 0.f}; }
            else { const float* ml = mod + (size_t)(l * 8 + b) * 6144;
                   A[j] = *(const f32x4*)(X.in(I_NMG) + l * D + c); Bm[j] = *(const f32x4*)(ml + 1024 + c); S[j] = *(const f32x4*)(ml + c); }
            if (MODE != 0) GF[j] = *(const f32x4*)(mod + (size_t)((l - 1) * 8 + b) * 6144 + 5120 + c);
        }
        __builtin_amdgcn_sched_barrier(0);
        if (MODE != 0) {
            const int e = X.lane & 31; const int p = (cnt_e + 255) & ~255;
            int incl = p;
#pragma unroll
            for (int o = 1; o < 32; o <<= 1) { const int t = sidx(incl, (X.lane & 32) + ((e - o) & 31)); if (e >= o) incl += t; }
            const int pst = incl - p;
            tp = sidx(pst, ee) + rk;
        }
        if (MODE != 2) {
#pragma unroll
            for (int j = 0; j < 4; ++j) A[j] = A[j] * (Bm[j] + 1.0f);
        }
        NormRow cur, nxt, nx2;
        norm_load<MODE>(cur, xsrc, Xb, Y2, r0, X.lane, sidx(tp, 0), sidx(tp, 1));
        norm_load<MODE>(nxt, xsrc, Xb, Y2, r0 + 1, X.lane, sidx(tp, 2), sidx(tp, 3));
#pragma unroll
        for (int rr = 0; rr < 16; ++rr) {
            const int row = r0 + rr;
            if (rr + 2 < 16) norm_load<MODE>(nx2, xsrc, Xb, Y2, row + 2, X.lane, sidx(tp, 2 * rr + 4), sidx(tp, 2 * rr + 5));
            f32x4 x[4];
#pragma unroll
            for (int j = 0; j < 4; ++j) { if (MODE == 0) x[j] = cur.x[j]; else { x[j][0] = (float)cur.xh[j][0]; x[j][1] = (float)cur.xh[j][1]; x[j][2] = (float)cur.xh[j][2]; x[j][3] = (float)cur.xh[j][3]; } }
            if (MODE != 0) {
                const float g0 = sidx(gt, 2 * rr), g1 = sidx(gt, 2 * rr + 1);
#pragma unroll
                for (int j = 0; j < 4; ++j) {
                    const f16x4 y0 = cur.y0[j], y1 = cur.y1[j];
                    f32x4 y; y[0] = g0 * (float)y0[0] + g1 * (float)y1[0]; y[1] = g0 * (float)y0[1] + g1 * (float)y1[1]; y[2] = g0 * (float)y0[2] + g1 * (float)y1[2]; y[3] = g0 * (float)y0[3] + g1 * (float)y1[3];
                    x[j] = x[j] + GF[j] * y;
                    if (MODE == 1) { u32x2 w; w.x = pkh(x[j][0], x[j][1]); w.y = pkh(x[j][2], x[j][3]); *(u32x2*)(Xb + (size_t)row * D + 4 * X.lane + 256 * j) = w; }
                }
            }
            if (MODE == 0) {
#pragma unroll
                for (int j = 0; j < 4; ++j) { u32x2 w; w.x = pkh(x[j][0], x[j][1]); w.y = pkh(x[j][2], x[j][3]); *(u32x2*)(Xb + (size_t)row * D + 4 * X.lane + 256 * j) = w; }
            }
            float s = 0.f;
#pragma unroll
            for (int j = 0; j < 4; ++j) s += (x[j][0] * x[j][0] + x[j][1] * x[j][1]) + (x[j][2] * x[j][2] + x[j][3] * x[j][3]);
            const float rstd = 1.0f / sqrtf(wave_sum(s, X.lane) * (1.f / D) + EPS);
#pragma unroll
            for (int j = 0; j < 4; ++j) {
                const f32x4 h = x[j] * rstd * A[j] + S[j];
                if (MODE == 2) { if (OUT_NT) __builtin_nontemporal_store(h, (f32x4*)(X.out() + (size_t)row * D + 4 * X.lane + 256 * j)); else *(f32x4*)(X.out() + (size_t)row * D + 4 * X.lane + 256 * j) = h; }
                else { u32x2 w; w.x = pkh(h[0], h[1]); w.y = pkh(h[2], h[3]); *(u32x2*)(H + (size_t)row * D + 4 * X.lane + 256 * j) = w; }
            }
            cur = nxt; nxt = nx2;
        }
    }
}

__device__ __forceinline__ void route_token(const LAS float* L, int row, int* eid, float* gate, LAS int* hist, LAS int* le, LAS int* lr, bool writer) {
    int gs = 0; float gm = L[0];
#pragma unroll
    for (int i = 1; i < 4; ++i) { const float v = L[i]; if (v > gm) { gm = v; gs = i; } }
    float den = 0.f;
#pragma unroll
    for (int i = 0; i < 4; ++i) den += expf(L[i] - gm);
    const float gwt = 1.0f / den;
    const LAS float* e = L + 4 + gs * 8;
    int i0 = 0; float v0 = e[0];
#pragma unroll
    for (int j = 1; j < 8; ++j) { const float v = e[j]; if (v > v0) { v0 = v; i0 = j; } }
    int i1 = (i0 == 0) ? 1 : 0; float v1 = e[i1];
#pragma unroll
    for (int j = 0; j < 8; ++j) { const float v = e[j]; if (j != i0 && v > v1) { v1 = v; i1 = j; } }
    const float t = expf(v1 - v0); const float p0 = 1.0f / (1.0f + t), p1 = t / (1.0f + t);
    if (writer) {
        const int e0 = gs * 8 + i0, e1 = gs * 8 + i1;
        eid[row * 2] = e0; eid[row * 2 + 1] = e1;
        gate[row * 2] = gwt * p0; gate[row * 2 + 1] = gwt * p1;
        const int a = (row & 127) * 2;
        le[a] = e0; le[a + 1] = e1;
        lr[a] = atomicAdd((int*)&hist[e0], 1); lr[a + 1] = atomicAdd((int*)&hist[e1], 1);
    }
}

__device__ __forceinline__ void norm2_router_mfma(const Ctx& X, int l) {
    const float* mod = (const float*)(X.ws + WS_MOD);
    const f16* Xb = (const f16*)(X.ws + WS_X); f16* H = (f16*)(X.ws + WS_H);
    const float* ssq = (const float*)(X.ws + WS_SSQ);
    int* eid = (int*)(X.ws + WS_EID); float* gate = (float*)(X.ws + WS_GATE); int* tokrank = (int*)(X.ws + WS_TOKPOS); int* list = (int*)(X.ws + WS_LIST);
    int* gcnt = (int*)(X.ws + WS_CTL) + CW_GCNT + l * 32;
    const f16* WR = (const f16*)(X.ws + WS_WR) + (size_t)l * 32 * 3 * 2 * 64 * 8;
    LAS float* Ac = (LAS float*)X.lds;
    LAS float* Sc = (LAS float*)(X.lds + 4096);
    LAS float* lbuf = (LAS float*)(X.lds + 8192 + X.wave * 3072);
    LAS int* hist = (LAS int*)(X.lds + 32768);
    LAS int* gbase = hist + 32;
    LAS int* le = hist + 64;
    LAS int* lr = hist + 320;
    const int r = X.lane & 15, q = X.lane >> 4;
    for (int ch = X.vcu; ch < T / 128; ch += X.G) {
        const int b = (ch * 128) >> 12;
        const float* ml = mod + (size_t)(l * 8 + b) * 6144;
        const int r0 = ch * 128 + X.wave * 16, row = r0 + r;
        const f16* xp = Xb + (size_t)row * D + 8 * q; f16* hp = H + (size_t)row * D + 8 * q;
        f16x8 xa[8], xb[8];
#pragma unroll
        for (int k = 0; k < 8; ++k) { xa[k] = *(const f16x8*)(xp + 32 * k); xb[k] = *(const f16x8*)(xp + 32 * (8 + k)); }
        const f32x4* sp = (const f32x4*)(ssq + (size_t)row * SSQ_SLOTS); const f32x4 s0 = sp[0], s1 = sp[1], s2 = sp[2], s3 = sp[3];
        LAS unsigned char* WL = X.lds + 40960;
        u32x4 wf[12]; const unsigned wvoff = (unsigned)X.tid * 16u;
#pragma unroll
        for (int k = 0; k < 12; ++k) { const char* wk = (const char*)WR + (size_t)k * (NTHREADS * 16); asm volatile("" : "+s"(wk)); wf[k] = *(const u32x4*)(wk + wvoff); }
        for (int c = X.tid; c < D; c += NTHREADS) { Ac[c] = X.in(I_NFG)[l * D + c] * (1.0f + ml[4096 + c]); Sc[c] = ml[3072 + c]; }
        if (X.tid < 32) hist[X.tid] = 0;
#pragma unroll
        for (int k = 0; k < 12; ++k) *(LAS u32x4*)(WL + (size_t)(X.tid + k * NTHREADS) * 16) = wf[k];
        __syncthreads();
        float rstd;
        { const float tot = ((s0[0] + s0[1]) + (s0[2] + s0[3])) + ((s1[0] + s1[1]) + (s1[2] + s1[3])) + ((s2[0] + s2[1]) + (s2[2] + s2[3])) + ((s3[0] + s3[1]) + (s3[2] + s3[3]));
          rstd = 1.0f / sqrtf(tot * (1.f / D) + EPS); }
#pragma unroll
        for (int k = 0; k < 12; ++k) { const char* wk = (const char*)WR + (size_t)(12 + k) * (NTHREADS * 16); asm volatile("" : "+s"(wk)); wf[k] = *(const u32x4*)(wk + wvoff); }
        f32x4 acc[3];
#pragma unroll
        for (int nb = 0; nb < 3; ++nb) acc[nb] = (f32x4){0.f, 0.f, 0.f, 0.f};
#define ROUTER_STEP(S_, XH_) do { const int s = (S_); const f16x8 xh = (XH_); \
            f16x8 bh[3], bl[3]; _Pragma("unroll") for (int nb = 0; nb < 3; ++nb) { bh[nb] = *(const LAS f16x8*)(WL + ((((s & 15) * 3 + nb) * 2 + 0) * 64 + X.lane) * 16); bl[nb] = *(const LAS f16x8*)(WL + ((((s & 15) * 3 + nb) * 2 + 1) * 64 + X.lane) * 16); } \
            f32x4 x0, x1; _Pragma("unroll") for (int j = 0; j < 4; ++j) { x0[j] = (float)xh[j]; x1[j] = (float)xh[4 + j]; } \
            const f32x4 a0 = *(const LAS f32x4*)(Ac + 32 * s + 8 * q), a1 = *(const LAS f32x4*)(Ac + 32 * s + 8 * q + 4); \
            const f32x4 c0 = *(const LAS f32x4*)(Sc + 32 * s + 8 * q), c1 = *(const LAS f32x4*)(Sc + 32 * s + 8 * q + 4); \
            const f32x4 h0 = x0 * rstd * a0 + c0, h1 = x1 * rstd * a1 + c1; \
            f16x8 hi, lo; _Pragma("unroll") for (int j = 0; j < 4; ++j) { hi[j] = (f16)h0[j]; hi[4 + j] = (f16)h1[j]; lo[j] = (f16)(h0[j] - (float)hi[j]); lo[4 + j] = (f16)(h1[j] - (float)hi[4 + j]); } \
            *(f16x8*)(hp + 32 * s) = hi; \
            _Pragma("unroll") for (int nb = 0; nb < 3; ++nb) { \
                acc[nb] = __builtin_amdgcn_mfma_f32_16x16x32_f16(hi, bh[nb], acc[nb], 0, 0, 0); \
                acc[nb] = __builtin_amdgcn_mfma_f32_16x16x32_f16(lo, bh[nb], acc[nb], 0, 0, 0); \
                acc[nb] = __builtin_amdgcn_mfma_f32_16x16x32_f16(hi, bl[nb], acc[nb], 0, 0, 0); } } while (0)
#pragma unroll
        for (int k = 0; k < 8; ++k) ROUTER_STEP(k, xa[k]);
#pragma unroll
        for (int k = 0; k < 8; ++k) xa[k] = *(const f16x8*)(xp + 32 * (16 + k));
#pragma unroll
        for (int k = 0; k < 8; ++k) ROUTER_STEP(8 + k, xb[k]);
#pragma unroll
        for (int k = 0; k < 8; ++k) xb[k] = *(const f16x8*)(xp + 32 * (24 + k));
        __syncthreads();
#pragma unroll
        for (int k = 0; k < 12; ++k) *(LAS u32x4*)(WL + (size_t)(X.tid + k * NTHREADS) * 16) = wf[k];
        __syncthreads();
#pragma unroll
        for (int k = 0; k < 8; ++k) ROUTER_STEP(16 + k, xa[k]);
#pragma unroll
        for (int k = 0; k < 8; ++k) ROUTER_STEP(24 + k, xb[k]);
#undef ROUTER_STEP
#pragma unroll
        for (int nb = 0; nb < 3; ++nb) {
            const int col = 16 * nb + r; float bias = 0.f;
            if (col < 4) bias = X.in(I_BGR)[l * 4 + col]; else if (col < 36) bias = X.in(I_BER)[l * 32 + col - 4];
#pragma unroll
            for (int j = 0; j < 4; ++j) lbuf[(4 * q + j) * 48 + col] = acc[nb][j] * (1.0f / 1024.0f) + bias;
        }
        LDS_WAIT(); asm volatile("" ::: "memory");
        route_token(lbuf + r * 48, r0 + r, eid, gate, hist, le, lr, X.lane < 16);
        __syncthreads();
        if (X.tid < 32) gbase[X.tid] = atomicAdd(gcnt + X.tid, hist[X.tid]);
        __syncthreads();
        if (X.tid < 256) { const int e = le[X.tid], rank = gbase[e] + lr[X.tid]; const int token = ch * 128 + (X.tid >> 1);
            tokrank[token * 2 + (X.tid & 1)] = rank; list[(size_t)e * LCAP + rank] = token; }
        __syncthreads();
    }
}

__device__ __forceinline__ void conv_part(const Ctx& X, int i, int row0);
__device__ __forceinline__ int sgu_swz(int d) { return (d ^ (d >> 3)) & 15; }
__device__ __forceinline__ void mixer_mfma(const Ctx& X, int i) {
    const f16* Z = (const f16*)(X.ws + WS_Z); f16* YC = (f16*)(X.ws + WS_YCAT);
    const float* gv = X.in(I_SGUG) + (size_t)i * 512; const float* bsp = X.in(I_BSP) + (size_t)i * 8 * 128;
    const f16* WSP = (const f16*)(X.ws + WS_WSP) + (size_t)i * 8 * 128 * 128;
    const int hd = X.wave;
    LAS unsigned char* Tb = X.lds + hd * 16384;
    for (int ch = X.vcu; ch < T / 128; ch += X.G) {
        const int row0 = ch * 128;
        const int d8 = X.lane & 7, tsub = X.lane >> 3;
        f16x8 vin[16];
#pragma unroll
        for (int it = 0; it < 16; ++it) vin[it] = LDNT_Z((const f16x8*)(Z + (size_t)(row0 + 8 * it + tsub) * INC + 512 + hd * 64 + 8 * d8));
        conv_part(X, i, row0);
        const int fr = X.lane & 15, q4 = X.lane >> 4;
        f16x4 ur[8][4];
#pragma unroll
        for (int tb = 0; tb < 4; ++tb)
#pragma unroll
            for (int db = 0; db < 4; ++db) ur[tb][db] = LDNT_Z((const f16x4*)(Z + (size_t)(row0 + 16 * tb + fr) * INC + hd * 64 + 16 * db + 4 * q4));
        {
            float g[8]; unsigned aj[8];
#pragma unroll
            for (int j = 0; j < 8; ++j) { g[j] = gv[hd * 64 + 8 * d8 + j]; const int d = 8 * d8 + j; aj[j] = (unsigned)(hd * 16384 + d * 256 + (sgu_swz(d) << 4) + tsub * 2); }
#pragma unroll
            for (int it = 0; it < 16; ++it) {
                const f16x8 v = vin[it];
                float f[8]; float ss = 0.f;
#pragma unroll
                for (int j = 0; j < 8; ++j) { f[j] = (float)v[j]; ss += f[j] * f[j]; }
                ss += dpp_f(ss, 0xB1); ss += dpp_f(ss, 0x4E); ss += dpp_f(ss, 0x141);
                unsigned key = (unsigned)it << 4; asm volatile("" : "+v"(key), "+v"(ss));
                const float rs = 1.0f / sqrtf(ss * (1.f / 64.f) + EPS);
#pragma unroll
                for (int j = 0; j < 8; ++j) *(LAS f16*)(X.lds + (aj[j] ^ key)) = (f16)(f[j] * rs * g[j]);
            }
        }
        f16x8 Bw[8][4];
        int fr2 = fr; asm volatile("" : "+v"(fr2));
#pragma unroll
        for (int tb = 0; tb < 6; ++tb)
#pragma unroll
            for (int ks = 0; ks < 4; ++ks) if (ks <= (tb >> 1)) Bw[tb][ks] = *(const f16x8*)(WSP + (size_t)(hd * 128 + 16 * tb + fr2) * 128 + 8 * q4 + 32 * ks);
        float bias[4];
#pragma unroll
        for (int tb = 0; tb < 4; ++tb) bias[tb] = bsp[hd * 128 + 16 * tb + fr2];
        LDS_WAIT(); asm volatile("" ::: "memory");
        {
            f16x8 Af[4][4];
#pragma unroll
            for (int db = 0; db < 4; ++db)
#pragma unroll
                for (int ks = 0; ks < 2; ++ks) { const int d = 16 * db + fr; Af[db][ks] = *(const LAS f16x8*)(Tb + d * 256 + (((4 * ks + q4) ^ sgu_swz(d)) << 4)); }
#pragma unroll
            for (int tb = 4; tb < 8; ++tb)
#pragma unroll
                for (int db = 0; db < 4; ++db) ur[tb][db] = LDNT_Z((const f16x4*)(Z + (size_t)(row0 + 16 * tb + fr) * INC + hd * 64 + 16 * db + 4 * q4));
#pragma unroll
            for (int tb = 0; tb < 8; ++tb) {
                if (tb == 4) {
#pragma unroll
                    for (int db = 0; db < 4; ++db)
#pragma unroll
                        for (int ks = 2; ks < 4; ++ks) { const int d = 16 * db + fr; Af[db][ks] = *(const LAS f16x8*)(Tb + d * 256 + (((4 * ks + q4) ^ sgu_swz(d)) << 4)); }
#pragma unroll
                    for (int t2 = 0; t2 < 4; ++t2) bias[t2] = bsp[hd * 128 + 16 * (4 + t2) + fr2];
#pragma unroll
                    for (int t2 = 6; t2 < 8; ++t2)
#pragma unroll
                        for (int ks = 0; ks < 4; ++ks) Bw[t2][ks] = *(const f16x8*)(WSP + (size_t)(hd * 128 + 16 * t2 + fr2) * 128 + 8 * q4 + 32 * ks);
                }
                const int t = 16 * tb + fr;
                f32x4 acc[4];
#pragma unroll
                for (int db = 0; db < 4; ++db) acc[db] = (f32x4){0.f, 0.f, 0.f, 0.f};
#pragma unroll
                for (int ks = 0; ks < 4; ++ks) {
                    if (ks <= (tb >> 1)) {
#pragma unroll
                        for (int db = 0; db < 4; ++db) acc[db] = __builtin_amdgcn_mfma_f32_16x16x32_f16(Af[db][ks], Bw[tb][ks], acc[db], 0, 0, 0);
                    }
                }
#pragma unroll
                for (int db = 0; db < 4; ++db) {
                    const f16x4 u = ur[tb][db]; const float bs = bias[tb & 3];
                    u32x2 w; w.x = pkh((float)u[0] * (acc[db][0] + bs), (float)u[1] * (acc[db][1] + bs)); w.y = pkh((float)u[2] * (acc[db][2] + bs), (float)u[3] * (acc[db][3] + bs));
                    *(u32x2*)(YC + (size_t)(row0 + t) * D + hd * 64 + 16 * db + 4 * q4) = w;
                }
            }
        }
        LDS_WAIT(); asm volatile("" ::: "memory");
        asm volatile("s_waitcnt vmcnt(0)" ::: "memory"); __syncthreads();
        if (X.tid == 0) __hip_atomic_store((unsigned*)(X.ws + WS_CTL) + CW_FLAG + i * 256 + ch, 1u, __ATOMIC_RELAXED, __HIP_MEMORY_SCOPE_AGENT);
    }
}

__device__ __forceinline__ void conv_part(const Ctx& X, int i, int row0) {
    const f16* Z = (const f16*)(X.ws + WS_Z); f16* YC = (f16*)(X.ws + WS_YCAT);
    const float* cw = X.in(I_CONVW) + (size_t)i * 3 * 512;
    const int ch0 = 8 * X.lane;
    float w0[8], w1[8], w2[8];
#pragma unroll
    for (int j = 0; j < 8; ++j) { w0[j] = cw[ch0 + j]; w1[j] = cw[512 + ch0 + j]; w2[j] = cw[1024 + ch0 + j]; }
    const int t0 = row0 + 16 * X.wave;
    float zm2[8], zm1[8];
#pragma unroll
    for (int j = 0; j < 8; ++j) { zm2[j] = 0.f; zm1[j] = 0.f; }
    if ((t0 & (SEQ - 1)) >= 2) {
        const f16x8 c2 = *(const f16x8*)(Z + (size_t)(t0 - 2) * INC + 1536 + ch0), x2 = *(const f16x8*)(Z + (size_t)(t0 - 2) * INC + 2048 + ch0);
        const f16x8 c1 = *(const f16x8*)(Z + (size_t)(t0 - 1) * INC + 1536 + ch0), x1 = *(const f16x8*)(Z + (size_t)(t0 - 1) * INC + 2048 + ch0);
#pragma unroll
        for (int j = 0; j < 8; ++j) { zm2[j] = (float)c2[j] * (float)x2[j]; zm1[j] = (float)c1[j] * (float)x1[j]; }
    }
    f16x8 rb[4], rc[4], rx[4];
#pragma unroll
    for (int k = 0; k < 4; ++k) { const size_t row = (size_t)(t0 + k); rb[k] = LDNT_Z((const f16x8*)(Z + row * INC + 1024 + ch0)); rc[k] = LDNT_Z((const f16x8*)(Z + row * INC + 1536 + ch0)); rx[k] = LDNT_Z((const f16x8*)(Z + row * INC + 2048 + ch0)); }
#pragma unroll
    for (int rr = 0; rr < 16; ++rr) {
        const size_t row = (size_t)(t0 + rr);
        const f16x8 bg = rb[rr & 3], cg = rc[rr & 3], xi = rx[rr & 3];
        if (rr + 4 < 16) { const size_t rn = row + 4; rb[rr & 3] = LDNT_Z((const f16x8*)(Z + rn * INC + 1024 + ch0)); rc[rr & 3] = LDNT_Z((const f16x8*)(Z + rn * INC + 1536 + ch0)); rx[rr & 3] = LDNT_Z((const f16x8*)(Z + rn * INC + 2048 + ch0)); }
        float o[8];
#pragma unroll
        for (int j = 0; j < 8; ++j) { const float zt = (float)cg[j] * (float)xi[j]; o[j] = (float)bg[j] * (w0[j] * zm2[j] + w1[j] * zm1[j] + w2[j] * zt); zm2[j] = zm1[j]; zm1[j] = zt; }
        u32x4 w; w.x = pkh(o[0], o[1]); w.y = pkh(o[2], o[3]); w.z = pkh(o[4], o[5]); w.w = pkh(o[6], o[7]);
        *(u32x4*)(YC + row * D + 512 + ch0) = w;
    }
}
template <int J>
__device__ __forceinline__ void poolprep_group(const f16* H, f16* P, int r0, int lane, bool halo) {
    constexpr int WIN = 2 << J, NH = WIN - 1;
    const f16* hp = H + (size_t)r0 * D + 4 * lane + 256 * J;
    f16x4 v[NH + 16];
#pragma unroll
    for (int i = 0; i < NH + 16; ++i) {
        if (i < NH) { v[i] = (f16x4){(f16)0.f, (f16)0.f, (f16)0.f, (f16)0.f}; if (halo) v[i] = *(const f16x4*)(hp + (ptrdiff_t)(i - NH) * D); }
        else v[i] = *(const f16x4*)(hp + (size_t)(i - NH) * D);
    }
    f32x4 S = (f32x4){0.f, 0.f, 0.f, 0.f};
#pragma unroll
    for (int i = 0; i < NH; ++i) { S[0] += (float)v[i][0]; S[1] += (float)v[i][1]; S[2] += (float)v[i][2]; S[3] += (float)v[i][3]; }
    const int ts0 = r0 & (SEQ - 1);
#pragma unroll
    for (int rr = 0; rr < 16; ++rr) {
        const f16x4 h = v[NH + rr];
        S[0] += (float)h[0]; S[1] += (float)h[1]; S[2] += (float)h[2]; S[3] += (float)h[3];
        const int ts = ts0 + rr; const float ic = 1.0f / (float)((ts + 1 < WIN) ? ts + 1 : WIN);
        u32x2 w; w.x = pkh(S[0] * ic - (float)h[0], S[1] * ic - (float)h[1]); w.y = pkh(S[2] * ic - (float)h[2], S[3] * ic - (float)h[3]);
        *(u32x2*)(P + (size_t)(r0 + rr) * D + 4 * lane + 256 * J) = w;
        const f16x4 o = v[rr];
        S[0] -= (float)o[0]; S[1] -= (float)o[1]; S[2] -= (float)o[2]; S[3] -= (float)o[3];
    }
}
__device__ __forceinline__ void poolprep_phase(const Ctx& X) {
    const f16* H = (const f16*)(X.ws + WS_H); f16* P = (f16*)(X.ws + WS_YCAT);
    const int gw = X.vcu * NWAVES + X.wave, NGW = X.G * NWAVES;
    for (int r0 = gw * 16; r0 < T; r0 += NGW * 16) {
        const bool halo = (r0 & (SEQ - 1)) != 0;
        poolprep_group<0>(H, P, r0, X.lane, halo); poolprep_group<1>(H, P, r0, X.lane, halo);
        poolprep_group<2>(H, P, r0, X.lane, halo); poolprep_group<3>(H, P, r0, X.lane, halo);
    }
}

constexpr int N_PHASES = 2 + 8 * DEPTH;
__global__ void __launch_bounds__(NTHREADS, 2) fwd(Args a) {
    extern __shared__ __attribute__((aligned(16))) unsigned char lds_raw[];
    Ctx X;
    X.lds = (LAS unsigned char*)lds_raw;
    ctx_refresh(X);
    X.G = gridDim.x; { const int bx = blockIdx.x; X.bidx = bx; X.vcu = (X.G % 8 == 0) ? (bx % 8) * (X.G / 8) + bx / 8 : bx; }
    for (int u = X.tid; u < 64; u += NTHREADS) ((LAS unsigned*)(X.lds + LDS_MISC))[u] = 0u;
    __syncthreads();
#if N_LAUNCH_MODE == 1
    XcdBarrier bar = xcd_barrier_post((unsigned*)(X.ws + WS_CTL) + CW_BAR, (volatile LAS unsigned*)(X.lds + LDS_MISC));
#define GRID_BAR() xcd_barrier(bar)
    bool hwmode = false;
#define LOCAL_BAR() do { if (hwmode) xcd_local_barrier((unsigned*)(X.ws + WS_CTL), bar.bar, bar.x, (unsigned)(X.G / 8), bar.st); else xcd_barrier(bar); } while (0)
#else
#define GRID_BAR() do {} while (0)
#define LOCAL_BAR() do {} while (0)
#endif
    const int lo = a.ph_lo, hi = a.ph_hi;
#define IN(k) (lo <= (k) && (k) < hi && (ctx_refresh(X), true))
#define SEAM(k) do { if (IN(k) && IN((k) + 1)) GRID_BAR(); } while (0)
#define LSEAM(k) do { if (IN(k) && IN((k) + 1)) LOCAL_BAR(); } while (0)

    if (IN(0)) { for (int rep = 0; rep < NREP(0); ++rep) p0_prologue(X); SEAM(0); }
#if N_LAUNCH_MODE == 1 && XCD_LOCAL_SEAMS
    {
        hwmode = xcd_census_even(bar.bar);
        if (hwmode) { const int rank = (int)((volatile LAS unsigned*)(X.lds + LDS_MISC))[3]; X.vcu = (int)bar.x * (X.G / 8) + rank; X.bidx = rank * 8 + (int)bar.x; }
    }
#endif

    for (int l = 0; l < DEPTH; ++l) {
        const int pb = 1 + 8 * l, i = l >> 1;
        const float* mod = (const float*)(X.ws + WS_MOD);
        f16* Xb = (f16*)(X.ws + WS_X); f16* H = (f16*)(X.ws + WS_H); f16* YC = (f16*)(X.ws + WS_YCAT); f16* Z = (f16*)(X.ws + WS_Z);
        if (IN(pb + 0)) { if (l == 0) { for (int rep = 0; rep < NREP(8); ++rep) norm_phase<0>(X, l); } else norm_phase<1>(X, l); LSEAM(pb + 0); }
        if ((l & 1) == 0) {
            if (IN(pb + 1)) {
                DenseSched S; S.init(T, INC, X.G, X.bidx, false, WGM_IN); EpiStoreF16<Z_NT> E{Z, INC};
                for (int rep = 0; rep < NREP(1); ++rep)
                run_gemm<DenseSched, EpiStoreF16<Z_NT>, false, false>(X, H, D, (const f16*)(X.ws + WS_WIN) + (size_t)i * INC * D, D, nullptr, S, E);
                LSEAM(pb + 1);
            }
            if (IN(pb + 2)) { for (int rep = 0; rep < NREP(2); ++rep) mixer_mfma(X, i); if (!hwmode) LSEAM(pb + 2); }
            if (IN(pb + 3)) {
                DenseSched S; S.init(T, D, X.G, X.bidx, false);
                if (IN(pb + 2)) {
                    if (X.tid == 0) { unsigned* fl = (unsigned*)(X.ws + WS_CTL) + CW_FLAG + i * 256; Unit u;
                        for (int i2 = 0; S.next(i2, u); ++i2) { const int c0 = u.arow >> 7; XB_SPIN(xb_ld(&fl[c0]) == 0u, bar.bar); XB_SPIN(xb_ld(&fl[c0 + 1]) == 0u, bar.bar); }
                        __builtin_amdgcn_fence(__ATOMIC_ACQUIRE, "agent"); asm volatile("s_waitcnt vmcnt(0)" ::: "memory"); }
                    __syncthreads(); }
                EpiResid<false> E{Xb, mod + (size_t)l * 8 * 6144 + 2048, nullptr, (float*)(X.ws + WS_SSQ)};
                run_gemm<DenseSched, EpiResid<false>, false, false>(X, YC, D, (const f16*)(X.ws + WS_WOUT) + (size_t)i * D * D, D, nullptr, S, E);
                LSEAM(pb + 3);
            }
        } else {
            if (IN(pb + 3)) {
                DenseSched S; S.init(T, D, X.G, X.bidx, true);
                { Unit u;
                  for (int i2 = 0; S.next(i2, u); ++i2) {
                      const bool halo0 = ((u.orow + 32 * X.wave) & (SEQ - 1)) != 0;
#pragma unroll
                      for (int k = 0; k < 2; ++k) { const int r0 = u.orow + 32 * X.wave + 16 * k; const bool halo = (k == 1) || halo0;
                          if (u.pn == 0) poolprep_group<0>(H, YC, r0, X.lane, halo); else if (u.pn == 1) poolprep_group<1>(H, YC, r0, X.lane, halo);
                          else if (u.pn == 2) poolprep_group<2>(H, YC, r0, X.lane, halo); else poolprep_group<3>(H, YC, r0, X.lane, halo); } }
                  asm volatile("s_waitcnt vmcnt(0)" ::: "memory"); __syncthreads();
                  if (X.tid == 0) { __builtin_amdgcn_fence(__ATOMIC_ACQUIRE, "agent"); asm volatile("s_waitcnt vmcnt(0)" ::: "memory"); }
                  __syncthreads(); }
                EpiResid<false> E{Xb, mod + (size_t)l * 8 * 6144 + 2048, nullptr, (float*)(X.ws + WS_SSQ)};
                run_gemm<DenseSched, EpiResid<false>, false, false>(X, YC, D, (const f16*)(X.ws + WS_WPOOL) + (size_t)i * 4 * 256 * 256, 256, nullptr, S, E);
                LSEAM(pb + 3);
            }
        }
        if (IN(pb + 4)) { if (l > 0) moe_convert_batches(X, l, 1 << 30); norm2_router_mfma(X, l); SEAM(pb + 4); }
        if (IN(pb + 6)) {
            moe_tables(X, l);
            MoeSched S{(const LAS int*)(X.lds + LDS_TAB), X.G, X.vcu, 128, true}; EpiSiluMul E{(f16*)(X.ws + WS_ACT)};
            const int n_units = 4 * ((const LAS int*)(X.lds + LDS_TAB))[64];
            LAS int* ltok = (LAS int*)(X.lds + LDS_TAB + 2048);
            { MoeSched S0 = S; S0.lds_list = false; Unit u;
              int tk[6]; bool pad[6];
#pragma unroll
              for (int i2 = 0; i2 < 6; ++i2) { const bool ok = S0.next(i2, u); pad[i2] = !(ok && X.tid < u.nvalid);
                  tk[i2] = ((const int*)(X.ws + WS_LIST))[(pad[i2] || X.tid >= 256) ? 0 : u.lbase + X.tid]; }
              __builtin_amdgcn_sched_barrier(0);
#pragma unroll
              for (int i2 = 0; i2 < 6; ++i2) if (X.tid < 256) ltok[i2 * 256 + X.tid] = pad[i2] ? 0 : tk[i2];
              __syncthreads(); }
            run_gemm<MoeSched, EpiSiluMul, true, true>(X, H, D, (const f16*)(X.ws + WS_W1) + (size_t)l * 32 * 1024 * 1024, D, ltok, S, E);
            if (hwmode && X.tid == 0) xb_add((unsigned*)(X.ws + WS_CTL) + CW_QCNT + l * 64 + (__builtin_amdgcn_readfirstlane(X.vcu) >> 2), 1u);
            if (l + 1 < DEPTH) { const int mine = (n_units - X.vcu + X.G - 1) / X.G, most = (n_units + X.G - 1) / X.G; if (most > mine) moe_convert_batches(X, l + 1, (most - mine) * TAIL_Q1); }
            if (hwmode) { if (IN(pb + 7)) { if (X.tid == 0) { unsigned* qc = (unsigned*)(X.ws + WS_CTL) + CW_QCNT + l * 64 + (__builtin_amdgcn_readfirstlane(X.vcu) >> 2);
                        XB_SPIN(xb_ld(qc) < 4u, bar.bar); __builtin_amdgcn_fence(__ATOMIC_ACQUIRE, "agent"); asm volatile("s_waitcnt vmcnt(0)" ::: "memory"); }
                    __syncthreads(); } }
            else LSEAM(pb + 6);
        }
        if (IN(pb + 7)) {
            moe_tables(X, l);
            MoeSched S{(const LAS int*)(X.lds + LDS_TAB), X.G, X.vcu, 256, false}; EpiStoreF16<Y2_NT> E{(f16*)(X.ws + WS_Y2), D};
            const int n_units = 4 * ((const LAS int*)(X.lds + LDS_TAB))[64];
            for (int rep = 0; rep < NREP(6); ++rep)
            run_gemm<MoeSched, EpiStoreF16<Y2_NT>, false, false>(X, (const f16*)(X.ws + WS_ACT), DE, (const f16*)(X.ws + WS_W2) + (size_t)l * 32 * 1024 * 512, DE, nullptr, S, E);
            if (l + 1 < DEPTH) { const int mine = (n_units - X.vcu + X.G - 1) / X.G, most = (n_units + X.G - 1) / X.G; if (most > mine) moe_convert_batches(X, l + 1, (most - mine) * TAIL_Q2); }
            SEAM(pb + 7);
        }
    }
    if (IN(1 + 8 * DEPTH)) norm_phase<2>(X, DEPTH);
#undef IN
#undef SEAM
#undef LSEAM
}

extern "C" void kernel_launch(void* const* d_in, const int* in_sizes, int n_in, void* d_out, int out_size, void* d_ws, size_t ws_size, hipStream_t stream) {
    static int grid = 0;
    if (grid == 0) {
        if (n_in != 22 || out_size != T * D || ws_size < WS_END) { fprintf(stderr, "kernel_launch: unexpected shapes (n_in %d out %d ws %zu, need %zu)\n", n_in, out_size, ws_size, (size_t)WS_END); grid = -1; return; }
        int dev = 0, cus = 0, per_cu = 0;
        if (hipGetDevice(&dev) != hipSuccess || hipDeviceGetAttribute(&cus, hipDeviceAttributeMultiprocessorCount, dev) != hipSuccess) { grid = -1; return; }
        if (hipFuncSetAttribute((const void*)fwd, hipFuncAttributeMaxDynamicSharedMemorySize, LDS_BYTES) != hipSuccess) { fprintf(stderr, "kernel_launch: hipFuncSetAttribute failed\n"); grid = -1; return; }
        if (hipOccupancyMaxActiveBlocksPerMultiprocessor(&per_cu, (const void*)fwd, NTHREADS, LDS_BYTES) != hipSuccess || per_cu < 1) { fprintf(stderr, "kernel_launch: occupancy query says %d\n", per_cu); }
        (void)hipGetLastError();
        grid = cus;
    }
    if (grid < 0) return;
    (void)hipMemsetAsync((char*)d_ws + WS_CTL, 0, CTL_ZERO_BYTES, stream);
    Args a{};
    for (int i = 0; i < 22; ++i) a.in[i] = (const float*)d_in[i];
    a.out = (float*)d_out; a.ws = (unsigned char*)d_ws;
#if N_LAUNCH_MODE == 1
    a.ph_lo = 0; a.ph_hi = N_PHASES;
    hipLaunchKernelGGL(fwd, dim3(grid), dim3(NTHREADS), LDS_BYTES, stream, a);
#else
    for (int p = 0; p < N_PHASES; ++p) {
        if (p >= 1 && p < 1 + 8 * DEPTH) { const int l = (p - 1) / 8, j = (p - 1) % 8; if (((l & 1) && (j == 1 || j == 2)) || j == 5) continue; }
        a.ph_lo = p; a.ph_hi = p + 1;
        hipLaunchKernelGGL(fwd, dim3(grid), dim3(NTHREADS), LDS_BYTES, stream, a);
    }
#endif
}
```
